# Optimizing an MI355X kernel written in HIP

```python
import jax, jax.numpy as jnp
from jax import lax
import numpy as np

D_MODEL = 1024
BATCH = 16
SEQ = 2048
DEPTH = 4
DEC_BATCH = 8
DEC_SEQ = 4096
PAST_LEN = 128

GRID_W = 64
HG_HEADS = 4
HG_DK = 128
HG_DV = 128
HG_KEY_WIDTH = HG_HEADS * HG_DK
HG_WIDTH = HG_HEADS * HG_DV
HG_CHUNK = 32
NA_HEADS = 8
NA_DH = 64
NA_WIDTH = NA_HEADS * NA_DH
WIN_ROWS = 8
WIN_COLS = 16
MIX_WIDTH = HG_WIDTH + NA_WIDTH
D_FF = 256 * ((8 * D_MODEL // 3 + 255) // 256)
EPS = 1e-6
IN_SIZES = (HG_KEY_WIDTH, HG_KEY_WIDTH, HG_KEY_WIDTH, HG_WIDTH, HG_WIDTH, NA_WIDTH, NA_WIDTH, NA_WIDTH)
IN_WIDTH = sum(IN_SIZES)

kernel_name = "hybrid_hgrn2_natten_macaron_adaln_encoder"


def _rms_norm(x, g):
    xf = x.astype(jnp.float32)
    y = xf * lax.rsqrt(jnp.mean(xf * xf, axis=-1, keepdims=True) + EPS)
    return (y * g.astype(jnp.float32)).astype(x.dtype)


def _modulate(n, m):
    return n * (1 + m[:, 1]) + m[:, 0]


def _swiglu(h, w_gate, w_up, w_down):
    return (jax.nn.silu(h @ w_gate) * (h @ w_up)) @ w_down


def _lower_bounds(p):
    sm = jax.nn.softmax(p.astype(jnp.float32), axis=0)
    return jnp.cumsum(sm, axis=0) - sm[0]


def _gla_chunk_scan(q, k, v, log_f):
    B, L, H, DK = q.shape
    DV = v.shape[-1]
    n = L // HG_CHUNK

    def to_chunks(a):
        return a.reshape(B, n, HG_CHUNK, H, a.shape[-1]).transpose(1, 0, 3, 2, 4)

    incl = jnp.tril(jnp.ones((HG_CHUNK, HG_CHUNK), dtype=bool))

    def step(S, blk):
        qc, kc, vc, gc = blk
        b = jnp.cumsum(gc, axis=2)
        b_last = b[:, :, -1]
        inter = jnp.einsum('bhik,bhkv->bhiv', qc * jnp.exp(b), S)
        rel = jnp.where(incl[:, :, None], b[:, :, :, None, :] - b[:, :, None, :, :], -jnp.inf)
        scores = jnp.einsum('bhik,bhjk,bhijk->bhij', qc, kc, jnp.exp(rel))
        intra = jnp.einsum('bhij,bhjv->bhiv', scores, vc)
        S = jnp.exp(b_last)[..., None] * S + jnp.einsum(
            'bhjk,bhjv->bhkv', kc * jnp.exp(b_last[:, :, None] - b), vc)
        return S, inter + intra

    S0 = jnp.zeros((B, H, DK, DV), jnp.float32)
    _, o = lax.scan(step, S0, (to_chunks(q), to_chunks(k), to_chunks(v), to_chunks(log_f)))
    return o.transpose(1, 0, 3, 2, 4).reshape(B, L, H, DV)


def _hgrn2_bidir(hq, hf_f, hf_b, hi, hg, lb_f, lb_b, norm_g):
    B, L, _ = hq.shape
    q = jax.nn.silu(hq.astype(jnp.float32)).reshape(B, L, HG_HEADS, HG_DK)
    v = hi.astype(jnp.float32).reshape(B, L, HG_HEADS, HG_DV)
    f_f = (lb_f + (1 - lb_f) * jax.nn.sigmoid(hf_f.astype(jnp.float32))).reshape(B, L, HG_HEADS, HG_DK)
    f_b = (lb_b + (1 - lb_b) * jax.nn.sigmoid(hf_b.astype(jnp.float32))).reshape(B, L, HG_HEADS, HG_DK)
    o_f = _gla_chunk_scan(q, 1 - f_f, v, jnp.log(f_f))
    flip = lambda a: jnp.flip(a, axis=1)
    o_b = flip(_gla_chunk_scan(flip(q), flip(1 - f_b), flip(v), flip(jnp.log(f_b))))
    o = _rms_norm(o_f + o_b, norm_g).reshape(B, L, HG_WIDTH)
    return (o * jax.nn.silu(hg.astype(jnp.float32))).astype(hq.dtype)


def _neighbourhood_attention(q, k, v, rpb):
    B, L, H, dh = q.shape
    rows = L // GRID_W
    wr = min(WIN_ROWS, rows)
    grid = lambda a: a.reshape(B, rows, GRID_W, H, dh).transpose(0, 3, 1, 2, 4)
    qg, kg, vg = grid(q), grid(k), grid(v)
    qcol = np.arange(GRID_W)
    c0 = np.clip(qcol - WIN_COLS // 2, 0, GRID_W - WIN_COLS)
    col_mask = jnp.asarray((qcol[None, :] >= c0[:, None]) & (qcol[None, :] < c0[:, None] + WIN_COLS))
    rel_c = jnp.asarray(np.clip(qcol[None, :] - qcol[:, None], -(WIN_COLS - 1), WIN_COLS - 1) + WIN_COLS - 1)
    scale = dh ** -0.5

    def row_block(r):
        r0 = jnp.clip(r - wr // 2, 0, rows - wr)
        kb = lax.dynamic_slice_in_dim(kg, r0, wr, axis=2)
        vb = lax.dynamic_slice_in_dim(vg, r0, wr, axis=2)
        qr = lax.dynamic_index_in_dim(qg, r, axis=2, keepdims=False)
        s = jnp.einsum('bhqd,bhrkd->bhqrk', qr, kb).astype(jnp.float32) * scale
        rel_r = r0 + jnp.arange(wr) - r + (WIN_ROWS - 1)
        bias = rpb[:, rel_r[None, :, None], rel_c[:, None, :]].astype(jnp.float32)
        s = jnp.where(col_mask[:, None, :], s + bias[None], -jnp.inf)
        p = jax.nn.softmax(s, axis=(-2, -1)).astype(vb.dtype)
        return jnp.einsum('bhqrk,bhrkd->bhqd', p, vb)

    out = lax.map(row_block, jnp.arange(rows))
    return out.transpose(1, 0, 3, 2, 4).reshape(B, L, H * dh)


def _mixer(h, w_in_l, w_out_l, lb_f, lb_b, hg_norm_g_l, qn_g, kn_g, rpb_l):
    B, L, _ = h.shape
    proj = h @ w_in_l
    offs = np.cumsum(IN_SIZES)[:-1].tolist()
    hq, hf_f, hf_b, hi, hg, nq, nk, nv = jnp.split(proj, offs, axis=-1)
    o_hg = _hgrn2_bidir(hq, hf_f, hf_b, hi, hg, lb_f, lb_b, hg_norm_g_l)
    heads = lambda a: a.reshape(B, L, NA_HEADS, NA_DH)
    o_na = _neighbourhood_attention(_rms_norm(heads(nq), qn_g), _rms_norm(heads(nk), kn_g), heads(nv), rpb_l)
    return jnp.concatenate([o_hg, o_na], axis=-1) @ w_out_l


def _trunk(x, c, w_mod, b_mod, norm_g, ffn_w_gate, ffn_w_up, ffn_w_down, w_in, w_out,
           lbs_f, lbs_b, hg_norm_g, na_q_norm_g, na_k_norm_g, na_rpb):
    B = x.shape[0]
    for l in range(DEPTH):
        mod = (jax.nn.silu(c) @ w_mod[l] + b_mod[l]).reshape(B, 3, 3, D_MODEL)[:, :, :, None, :]
        h = _modulate(_rms_norm(x, norm_g[l, 0]), mod[:, 0])
        x = x + 0.5 * mod[:, 0, 2] * _swiglu(h, ffn_w_gate[l, 0], ffn_w_up[l, 0], ffn_w_down[l, 0])
        h = _modulate(_rms_norm(x, norm_g[l, 1]), mod[:, 1])
        x = x + mod[:, 1, 2] * _mixer(h, w_in[l], w_out[l], lbs_f[l], lbs_b[l], hg_norm_g[l],
                                      na_q_norm_g[l], na_k_norm_g[l], na_rpb[l])
        h = _modulate(_rms_norm(x, norm_g[l, 2]), mod[:, 2])
        x = x + 0.5 * mod[:, 2, 2] * _swiglu(h, ffn_w_gate[l, 1], ffn_w_up[l, 1], ffn_w_down[l, 1])
    return x


def setup_inputs(seed: int = 0) -> dict:
    key = jax.random.key(seed)
    ks = jax.random.split(key, 20)
    D = D_MODEL
    nrm = lambda k, shape, s: jax.random.normal(k, shape, jnp.float32) * s
    return {
        "x_prompt": nrm(ks[0], (BATCH, SEQ, D), 1.0),
        "x_sample": nrm(ks[1], (DEC_BATCH, DEC_SEQ, D), 1.0),
        "c_prompt": nrm(ks[2], (BATCH, D), 1.0),
        "c_sample": nrm(ks[3], (DEC_BATCH, D), 1.0),
        "w_mod": nrm(ks[4], (DEPTH, D, 9 * D), 0.5 * D ** -0.5),
        "b_mod": nrm(ks[5], (DEPTH, 9 * D), 0.02),
        "norm_g": 1.0 + nrm(ks[6], (DEPTH, 3, D), 0.02),
        "ffn_w_gate": nrm(ks[7], (DEPTH, 2, D, D_FF), D ** -0.5),
        "ffn_w_up": nrm(ks[8], (DEPTH, 2, D, D_FF), D ** -0.5),
        "ffn_w_down": nrm(ks[9], (DEPTH, 2, D_FF, D), D_FF ** -0.5),
        "w_in": nrm(ks[10], (DEPTH, D, IN_WIDTH), D ** -0.5),
        "w_out": nrm(ks[11], (DEPTH, MIX_WIDTH, D), MIX_WIDTH ** -0.5),
        "hg_lb_fwd": nrm(ks[12], (DEPTH, HG_KEY_WIDTH), 1.0),
        "hg_lb_bwd": nrm(ks[13], (DEPTH, HG_KEY_WIDTH), 1.0),
        "hg_norm_g": 1.0 + nrm(ks[14], (DEPTH, HG_DV), 0.02),
        "na_q_norm_g": 1.0 + nrm(ks[15], (DEPTH, NA_DH), 0.02),
        "na_k_norm_g": 1.0 + nrm(ks[16], (DEPTH, NA_DH), 0.02),
        "na_rpb": nrm(ks[17], (DEPTH, NA_HEADS, 2 * WIN_ROWS - 1, 2 * WIN_COLS - 1), 0.1),
    }


def reference(x_prompt, x_sample, c_prompt, c_sample, w_mod, b_mod, norm_g, ffn_w_gate, ffn_w_up,
              ffn_w_down, w_in, w_out, hg_lb_fwd, hg_lb_bwd, hg_norm_g, na_q_norm_g, na_k_norm_g, na_rpb):
    lbs_f = _lower_bounds(hg_lb_fwd)
    lbs_b = _lower_bounds(hg_lb_bwd)
    y_prompt = _trunk(x_prompt, c_prompt, w_mod, b_mod, norm_g, ffn_w_gate, ffn_w_up, ffn_w_down,
                      w_in, w_out, lbs_f, lbs_b, hg_norm_g, na_q_norm_g, na_k_norm_g, na_rpb)
    y_sample = _trunk(x_sample, c_sample, w_mod, b_mod, norm_g, ffn_w_gate, ffn_w_up, ffn_w_down,
                      w_in, w_out, lbs_f, lbs_b, hg_norm_g, na_q_norm_g, na_k_norm_g, na_rpb)
    return (y_prompt, y_sample)
```

```cpp
#include <hip/hip_runtime.h>
#include <hip/hip_cooperative_groups.h>
#include <cstdio>
#include <cstdint>
namespace cg = cooperative_groups;
namespace pg8 {
#define PG8_LAS __attribute__((address_space(3)))
typedef unsigned short bf16_t;
typedef short bf16x8 __attribute__((ext_vector_type(8)));
typedef float f32x4 __attribute__((ext_vector_type(4)));
typedef unsigned u32x4 __attribute__((ext_vector_type(4)));
constexpr int BM = 256, BK = 64, HALF = 128, HTB = HALF * BK * 2  , STAGE_BYTES = 8 * HTB, NXCD = 8, WGM = 8;

__host__ __device__ __forceinline__ int lds_byte(int r, int c) { const int st = (r >> 4) * 2 + (c >> 5), rr = r & 15, cc = c & 31, ob = rr * 64 + cc * 2; return st * 1024 + (ob ^ (((ob >> 9) & 1) << 5)); }
__host__ __device__ __forceinline__ void stage_rc(int b, int& R, int& C) { const int st = b / 1024, sb = b % 1024, swz = sb ^ (((sb >> 9) & 1) << 5); R = (st >> 1) * 16 + swz / 64; C = (st & 1) * 32 + (swz % 64) / 2; }
__host__ __device__ __forceinline__ int perm32(int rho) { const int n = rho >> 4, i = rho & 15; return 8 * (i >> 2) + 4 * n + (i & 3); }

struct Unit { int pm, pn; };
struct Gemm { const bf16_t* A; const bf16_t* Bt; int M, N, K; };

struct StaticOrder {
    int nM, nN, nwg, G, c;
    __host__ __device__ void init(int M, int N, int G_, int c_) { nM = M / BM; nN = N / BM; nwg = nM * nN; G = G_; c = c_; }
    __host__ __device__ bool next(int i, Unit& u) const {
        const long L = (long)i * G + c; if (L >= nwg) return false;
        int wgid = (int)L; { const int q = nwg / NXCD, r = nwg % NXCD, xcd = wgid % NXCD, off = wgid / NXCD; wgid = (xcd < r ? xcd * (q + 1) : r * (q + 1) + (xcd - r) * q) + off; }
        const int nig = WGM * nN, gid = wgid / nig, fm = gid * WGM, gsz = (nM - fm) < WGM ? (nM - fm) : WGM;
        u.pm = fm + ((wgid % nig) % gsz); u.pn = (wgid % nig) / gsz; return true;
    }
    __device__ __forceinline__ void a_ready(const Unit&) const {}
    __device__ __forceinline__ void done(const Unit&) const {}
};

__device__ __forceinline__ unsigned cvt_pk_bf16(float lo, float hi) { unsigned r; asm volatile("v_cvt_pk_bf16_f32 %0, %1, %2" : "=v"(r) : "v"(lo), "v"(hi)); return r; }
typedef float f32x2 __attribute__((ext_vector_type(2)));
__device__ __forceinline__ f32x2 gelu_pk(f32x2 v) {
    const f32x2 av = __builtin_elementwise_abs(v), d = av * 0.2316418882f + 1.0f;
    f32x2 t; t.x = __builtin_amdgcn_rcpf(d.x); t.y = __builtin_amdgcn_rcpf(d.y);
    f32x2 q = t * 0.5307027145f + (-0.7265760135f); q = q * t + 0.7107068705f; q = q * t + (-0.142248368f); q = q * t + 0.127414796f; q = q * t;
    const f32x2 s = (v * v) * (-0.72134752044f);
    f32x2 e; e.x = __builtin_amdgcn_exp2f(s.x); e.y = __builtin_amdgcn_exp2f(s.y);
    const f32x2 m = v * (q * e), r = v - m;
    f32x2 o; o.x = v.x < 0.f ? m.x : r.x; o.y = v.y < 0.f ? m.y : r.y; return o;
}

template <int ACT  > struct EpiBf16 {
    static constexpr bool PERM = true, AFTER_DRAIN = false; static_assert(ACT == 0 || ACT == 1, "EpiBf16: ACT is 0 (none) or 1 (gelu_pk)");
    bf16_t* O; int ldc; const float* bias; int split_cols; size_t split_stride; float scale0;
    __device__ __forceinline__ void operator()(const f32x4 (&acc)[2][2][4][2], const Unit& u, int wr, int wc, int fr, int fq) const {
        const int row0 = u.pm * BM + wr * 64 + fr; int colt = u.pn * BM; bf16_t* base = O;
        float sc = 1.f; if (split_cols) { const int t = colt / split_cols; base += (size_t)t * split_stride; colt -= t * split_cols; if (t == 0) sc = scale0; }
        const int col0 = colt + wc * 32 + 8 * fq, bcol0 = u.pn * BM + wc * 32 + 8 * fq;
        f32x4 bv[2][2];
#pragma unroll
        for (int bj = 0; bj < 2; ++bj)
#pragma unroll
            for (int n = 0; n < 2; ++n) bv[bj][n] = bias ? *(const f32x4*)(bias + bcol0 + bj * HALF + 4 * n) : (f32x4){0.f, 0.f, 0.f, 0.f};
#pragma unroll
        for (int ai = 0; ai < 2; ++ai)
#pragma unroll
            for (int m = 0; m < 4; ++m) { bf16_t* rowp = base + (size_t)(row0 + ai * HALF + m * 16) * ldc + col0;
#pragma unroll
                for (int bj = 0; bj < 2; ++bj) { f32x4 v0 = acc[ai][bj][m][0] + bv[bj][0], v1 = acc[ai][bj][m][1] + bv[bj][1];
                    if (ACT == 1) { f32x2 a = gelu_pk((f32x2){v0[0], v0[1]}), b = gelu_pk((f32x2){v0[2], v0[3]}), c = gelu_pk((f32x2){v1[0], v1[1]}), d = gelu_pk((f32x2){v1[2], v1[3]});
                        v0 = (f32x4){a.x, a.y, b.x, b.y}; v1 = (f32x4){c.x, c.y, d.x, d.y}; }
                    v0 = v0 * sc; v1 = v1 * sc; u32x4 w; w.x = cvt_pk_bf16(v0[0], v0[1]); w.y = cvt_pk_bf16(v0[2], v0[3]); w.z = cvt_pk_bf16(v1[0], v1[1]); w.w = cvt_pk_bf16(v1[2], v1[3]);
                    *(u32x4*)(rowp + bj * HALF) = w; } }
    }
};
template <class Epi, class Sched, bool ALIGN_EPI = false, bool SP2 = false>
__device__ __forceinline__ void gemm_phase(PG8_LAS unsigned char* lds, const Gemm g, const Sched& S, const Epi& E, const int tid_in) {
    const int tid = tid_in, wid = __builtin_amdgcn_readfirstlane(tid >> 6), lane = tid & 63, wr = wid >> 2, wc = wid & 3, fr = lane & 15, fq = lane >> 4;
    const int K = g.K, nt = K / BK;
    unsigned voffA[2], voffB[2];
#pragma unroll
    for (int i = 0; i < 2; ++i) { int R, C; stage_rc(tid * 16 + i * 8192, R, C); const int Rb = Epi::PERM ? ((R & ~31) + perm32(R & 31)) : R;
        voffA[i] = (unsigned)(R * K + C) * 2u; voffB[i] = (unsigned)(Rb * K + C) * 2u; }
    const size_t kstep = (size_t)(BK * 2);
    const size_t hstep = (size_t)HALF * K * 2;
    const size_t tstep = 2 * hstep;
    const unsigned ldsw = (unsigned)wid * 1024u;
    const int aoff = lds_byte(wr * 64 + fr, fq * 8), boff = lds_byte(wc * 32 + fr, fq * 8);
#define PG8_SA(b, h) (((b) * 2 + (h)) * HTB)
#define PG8_SB(b, h) ((4 + (b) * 2 + (h)) * HTB)
#define PG8_STAGE(bufoff, gbase, voff) do { _Pragma("unroll") for (int _i = 0; _i < 2; ++_i) \
        __builtin_amdgcn_global_load_lds((const unsigned*)((const char*)(gbase) + (voff)[_i]), (PG8_LAS unsigned*)(lds + (bufoff) + ldsw + _i * 8192), 16, 0, 0); } while (0)
#define PG8_LDA(dst, b, h) do { _Pragma("unroll") for (int m = 0; m < 4; ++m) _Pragma("unroll") for (int k = 0; k < 2; ++k) dst[m][k] = *(const PG8_LAS bf16x8*)(lds + PG8_SA(b, h) + aoff + m * 2048 + k * 1024); } while (0)
#define PG8_LDB(dst, b, h) do { _Pragma("unroll") for (int n = 0; n < 2; ++n) _Pragma("unroll") for (int k = 0; k < 2; ++k) dst[n][k] = *(const PG8_LAS bf16x8*)(lds + PG8_SB(b, h) + boff + n * 2048 + k * 1024); } while (0)
#define PG8_MMA(ai, bj, At, Bt) do { __builtin_amdgcn_s_setprio(1); _Pragma("unroll") for (int m = 0; m < 4; ++m) _Pragma("unroll") for (int n = 0; n < 2; ++n) _Pragma("unroll") for (int k = 0; k < 2; ++k) \
        acc[ai][bj][m][n] = __builtin_amdgcn_mfma_f32_16x16x32_bf16(Bt[n][k], At[m][k], acc[ai][bj][m][n], 0, 0, 0); __builtin_amdgcn_s_setprio(0); } while (0)
#define PG8_WAIT_V(n) asm volatile("s_waitcnt vmcnt(" #n ")" ::: "memory")
#define PG8_WAIT_L(n) asm volatile("s_waitcnt lgkmcnt(" #n ")" ::: "memory")
#define PG8_BAR __builtin_amdgcn_s_barrier()
#define PG8_SCHED __builtin_amdgcn_sched_barrier(0)
    Unit cur, nxt; int ui = 0;
    if (!S.next(0, cur)) return;
    f32x4 acc[2][2][4][2];
#pragma unroll
    for (int a = 0; a < 2; ++a)
#pragma unroll
        for (int b = 0; b < 2; ++b)
#pragma unroll
            for (int m = 0; m < 4; ++m)
#pragma unroll
                for (int n = 0; n < 2; ++n) acc[a][b][m][n] = (f32x4){0.f, 0.f, 0.f, 0.f};
    bf16x8 At[4][2], B0[2][2], B1[2][2];
    const char* cA = (const char*)g.A + (size_t)cur.pm * tstep; const char* cB = (const char*)g.Bt + (size_t)cur.pn * tstep;
    S.a_ready(cur);
    if constexpr (SP2) {
        PG8_STAGE(PG8_SB(0, 0), cB, voffB); PG8_STAGE(PG8_SB(0, 1), cB + hstep, voffB); PG8_STAGE(PG8_SA(0, 0), cA, voffA); PG8_STAGE(PG8_SA(0, 1), cA + hstep, voffA);
        if (wr == 1) PG8_BAR;
        PG8_WAIT_V(2); PG8_BAR;
        PG8_STAGE(PG8_SB(1, 0), cB + kstep, voffB); PG8_STAGE(PG8_SA(1, 0), cA + kstep, voffA); PG8_STAGE(PG8_SB(1, 1), cB + hstep + kstep, voffB);
        PG8_WAIT_V(6); PG8_BAR;
    } else {
        PG8_STAGE(PG8_SB(0, 0), cB, voffB); PG8_STAGE(PG8_SA(0, 0), cA, voffA); PG8_STAGE(PG8_SB(0, 1), cB + hstep, voffB); PG8_STAGE(PG8_SA(0, 1), cA + hstep, voffA);
        if (wr == 1) PG8_BAR;
        PG8_WAIT_V(4); PG8_BAR;
        PG8_STAGE(PG8_SB(1, 0), cB + kstep, voffB); PG8_STAGE(PG8_SA(1, 0), cA + kstep, voffA); PG8_STAGE(PG8_SB(1, 1), cB + hstep + kstep, voffB);
        PG8_WAIT_V(6); PG8_BAR;
    }
    for (;;) {
        const bool has_next = S.next(ui + 1, nxt);
        const char* nA = has_next ? (const char*)g.A + (size_t)nxt.pm * tstep : cA; const char* nB = has_next ? (const char*)g.Bt + (size_t)nxt.pn * tstep : cB;
        for (int t = 0; t < nt; t += 2) {
            const bool last = (t == nt - 2);
            const char* a1 = cA + (size_t)(t + 1) * kstep;
            const char* a2 = last ? nA : cA + (size_t)(t + 2) * kstep; const char* b2 = last ? nB : cB + (size_t)(t + 2) * kstep;
            const char* a3 = a2 + kstep; const char* b3 = b2 + kstep;
            if (last && has_next) S.a_ready(nxt);
            if constexpr (SP2) {
            PG8_LDB(B0, 0, 0); PG8_LDB(B1, 0, 1); PG8_SCHED; PG8_LDA(At, 0, 0); PG8_STAGE(PG8_SA(1, 1), a1 + hstep, voffA);
            PG8_WAIT_V(8); PG8_WAIT_L(0); PG8_BAR; PG8_MMA(0, 0, At, B0); PG8_MMA(0, 1, At, B1); PG8_BAR; PG8_SCHED;
            PG8_LDA(At, 0, 1); PG8_STAGE(PG8_SB(0, 0), b2, voffB); PG8_STAGE(PG8_SB(0, 1), b2 + hstep, voffB); PG8_STAGE(PG8_SA(0, 0), a2, voffA);
            PG8_WAIT_V(8); PG8_WAIT_L(0); PG8_BAR; PG8_MMA(1, 0, At, B0); PG8_MMA(1, 1, At, B1); PG8_BAR; PG8_SCHED;
            PG8_LDB(B0, 1, 0); PG8_LDB(B1, 1, 1); PG8_SCHED; PG8_LDA(At, 1, 0); PG8_STAGE(PG8_SA(0, 1), a2 + hstep, voffA);
            PG8_WAIT_V(8); PG8_WAIT_L(0); PG8_BAR; PG8_MMA(0, 0, At, B0); PG8_MMA(0, 1, At, B1); PG8_BAR; PG8_SCHED;
            PG8_LDA(At, 1, 1); PG8_STAGE(PG8_SB(1, 0), b3, voffB); PG8_STAGE(PG8_SB(1, 1), b3 + hstep, voffB); PG8_STAGE(PG8_SA(1, 0), a3, voffA);
            PG8_WAIT_V(8); PG8_WAIT_L(0); PG8_BAR; PG8_MMA(1, 0, At, B0); PG8_MMA(1, 1, At, B1); PG8_BAR; PG8_SCHED;
            } else {
            PG8_LDB(B0, 0, 0); PG8_SCHED; PG8_LDA(At, 0, 0); PG8_STAGE(PG8_SA(1, 1), a1 + hstep, voffA);
            PG8_WAIT_L(8); PG8_BAR; PG8_WAIT_L(0); PG8_MMA(0, 0, At, B0); PG8_BAR; PG8_SCHED;
            PG8_LDB(B1, 0, 1); PG8_STAGE(PG8_SB(0, 0), b2, voffB);
            PG8_BAR; PG8_WAIT_L(0); PG8_MMA(0, 1, At, B1); PG8_BAR;
            PG8_LDA(At, 0, 1); PG8_STAGE(PG8_SA(0, 0), a2, voffA);
            PG8_BAR; PG8_WAIT_L(0); PG8_MMA(1, 0, At, B0); PG8_BAR; PG8_SCHED;
            PG8_STAGE(PG8_SB(0, 1), b2 + hstep, voffB);
            PG8_WAIT_V(6); PG8_BAR; PG8_MMA(1, 1, At, B1); PG8_BAR;
            PG8_LDB(B0, 1, 0); PG8_SCHED; PG8_LDA(At, 1, 0); PG8_STAGE(PG8_SA(0, 1), a2 + hstep, voffA);
            PG8_WAIT_L(8); PG8_BAR; PG8_WAIT_L(0); PG8_MMA(0, 0, At, B0); PG8_BAR; PG8_SCHED;
            PG8_LDB(B1, 1, 1); PG8_STAGE(PG8_SB(1, 0), b3, voffB);
            PG8_BAR; PG8_WAIT_L(0); PG8_MMA(0, 1, At, B1); PG8_BAR;
            PG8_LDA(At, 1, 1); PG8_STAGE(PG8_SA(1, 0), a3, voffA);
            PG8_BAR; PG8_WAIT_L(0); PG8_MMA(1, 0, At, B0); PG8_BAR; PG8_SCHED;
            PG8_STAGE(PG8_SB(1, 1), b3 + hstep, voffB);
            PG8_WAIT_V(6); PG8_BAR; PG8_MMA(1, 1, At, B1); PG8_BAR;
            }
        }
        if constexpr (ALIGN_EPI) { if (wr == 0) PG8_BAR; }
        if constexpr (!Epi::AFTER_DRAIN) { E(acc, cur, wr, wc, fr, fq); S.done(cur); }
        if (!has_next) break;
#pragma unroll
        for (int a = 0; a < 2; ++a)
#pragma unroll
            for (int b = 0; b < 2; ++b)
#pragma unroll
                for (int m = 0; m < 4; ++m)
#pragma unroll
                    for (int n = 0; n < 2; ++n) acc[a][b][m][n] = (f32x4){0.f, 0.f, 0.f, 0.f};
        cur = nxt; cA = nA; cB = nB; ++ui;
        if constexpr (ALIGN_EPI) { if (wr == 1) PG8_BAR; }
    }
    PG8_WAIT_V(0);
    if constexpr (!ALIGN_EPI) { if (wr == 0) PG8_BAR; }
    PG8_BAR;
    if constexpr (Epi::AFTER_DRAIN) { E.fused(acc, cur, wr, wc, fr, fq, lds, wid, lane); S.done(cur); }
#undef PG8_SA
#undef PG8_SB
#undef PG8_STAGE
#undef PG8_LDA
#undef PG8_LDB
#undef PG8_MMA
#undef PG8_WAIT_V
#undef PG8_WAIT_L
#undef PG8_BAR
#undef PG8_SCHED
}
}

namespace pg8 {
__device__ __forceinline__ float silu_f(float g) { return g * __builtin_amdgcn_rcpf(1.0f + __expf(-g)); }
__device__ __forceinline__ float sigm_f(float g) { return __builtin_amdgcn_rcpf(1.0f + __expf(-g)); }
struct EpiSwiGLU {
    static constexpr bool PERM = true, AFTER_DRAIN = false;
    bf16_t* O; const float* ssq; const float* shw;
    __device__ __forceinline__ void operator()(const f32x4 (&acc)[2][2][4][2], const Unit& u, int wr, int wc, int fr, int fq) const {
        const int r00 = u.pm * BM;
        const int b = r00 < 32768 ? (r00 >> 11) : 16 + ((r00 - 32768) >> 12);
        const int row0 = r00 + wr * 64 + fr; const int col0 = u.pn * 128 + wc * 32 + 8 * fq;
        const float* sp = shw + (size_t)b * 5632 + u.pn * BM + wc * 32 + 8 * fq;
        const f32x4 sg0 = *(const f32x4*)(sp), sg1 = *(const f32x4*)(sp + 4), su0 = *(const f32x4*)(sp + HALF), su1 = *(const f32x4*)(sp + HALF + 4);
#pragma unroll
        for (int ai = 0; ai < 2; ++ai)
#pragma unroll
            for (int m = 0; m < 4; ++m) {
                const int row = row0 + ai * HALF + m * 16;
                const float rs = __builtin_amdgcn_rsqf(ssq[row] * (1.0f / 1024.0f) + 1e-6f);
                bf16_t* rowp = O + (size_t)row * 2816 + col0;
                const f32x4 g0 = acc[ai][0][m][0] * rs + sg0, g1 = acc[ai][0][m][1] * rs + sg1, u0 = acc[ai][1][m][0] * rs + su0, u1 = acc[ai][1][m][1] * rs + su1;
                u32x4 w;
                w.x = cvt_pk_bf16(silu_f(g0[0]) * u0[0], silu_f(g0[1]) * u0[1]);
                w.y = cvt_pk_bf16(silu_f(g0[2]) * u0[2], silu_f(g0[3]) * u0[3]);
                w.z = cvt_pk_bf16(silu_f(g1[0]) * u1[0], silu_f(g1[1]) * u1[1]);
                w.w = cvt_pk_bf16(silu_f(g1[2]) * u1[2], silu_f(g1[3]) * u1[3]);
                *(u32x4*)rowp = w;
            }
    }
};
struct EpiProj {
    static constexpr bool PERM = true, AFTER_DRAIN = false;
    bf16_t* O; const float* ssq; const float* shw;
    __device__ __forceinline__ void operator()(const f32x4 (&acc)[2][2][4][2], const Unit& u, int wr, int wc, int fr, int fq) const {
        const int r00 = u.pm * BM;
        const int b = r00 < 32768 ? (r00 >> 11) : 16 + ((r00 - 32768) >> 12);
        const int row0 = r00 + wr * 64 + fr; const int col0 = u.pn * BM + wc * 32 + 8 * fq;
        const int mode = (u.pn < 2 || u.pn == 8 || u.pn == 9) ? 1 : ((u.pn >= 2 && u.pn < 6) ? 2 : 0);
        const float* sp = shw + (size_t)b * 5632 + col0;
        f32x4 sv[2][2];
#pragma unroll
        for (int bj = 0; bj < 2; ++bj) { sv[bj][0] = *(const f32x4*)(sp + bj * HALF); sv[bj][1] = *(const f32x4*)(sp + bj * HALF + 4); }
#pragma unroll
        for (int ai = 0; ai < 2; ++ai)
#pragma unroll
            for (int m = 0; m < 4; ++m) { const int row = row0 + ai * HALF + m * 16;
                const float rs = __builtin_amdgcn_rsqf(ssq[row] * (1.0f / 1024.0f) + 1e-6f);
                bf16_t* rowp = O + (size_t)row * 4224 + col0;
#pragma unroll
                for (int bj = 0; bj < 2; ++bj) { f32x4 v0 = acc[ai][bj][m][0] * rs + sv[bj][0], v1 = acc[ai][bj][m][1] * rs + sv[bj][1];
                    if (mode == 1) {
#pragma unroll
                        for (int e = 0; e < 4; ++e) { v0[e] = silu_f(v0[e]); v1[e] = silu_f(v1[e]); }
                    } else if (mode == 2) {
#pragma unroll
                        for (int e = 0; e < 4; ++e) { v0[e] = sigm_f(v0[e]); v1[e] = sigm_f(v1[e]); }
                    }
                    u32x4 w; w.x = cvt_pk_bf16(v0[0], v0[1]); w.y = cvt_pk_bf16(v0[2], v0[3]); w.z = cvt_pk_bf16(v1[0], v1[1]); w.w = cvt_pk_bf16(v1[2], v1[3]);
                    *(u32x4*)(rowp + bj * HALF) = w; } }
    }
};
struct EpiRes {
    static constexpr bool PERM = true, AFTER_DRAIN = false;
    const float* xp; const float* xs; float* out; unsigned char* ws;
    int l, sub, fx;
    __device__ __forceinline__ void operator()(const f32x4 (&acc)[2][2][4][2], const Unit& u, int wr, int wc, int fr, int fq) const {
        constexpr size_t kMiB = 1u << 20;
        const int r00 = u.pm * BM;
        const int b = r00 < 32768 ? (r00 >> 11) : 16 + ((r00 - 32768) >> 12);
        const float* mod = (const float*)(ws + 4 * kMiB);
        const float* gp = mod + ((size_t)(l * 24 + b) * 9 + sub * 3 + 2) * 1024;
        const float coef = sub == 1 ? 1.0f : 0.5f;
        const int nl = sub == 2 ? l + 1 : l, nsub = sub == 2 ? 0 : sub + 1;
        const bool has_next = nl < 4;
        const int nidx = has_next ? nl * 3 + nsub : 0;
        bf16_t* Hn = (bf16_t*)(ws + (sub == 1 ? 576 : 64) * kMiB);
        float* ssqn = (float*)(ws + 1 * kMiB) + (size_t)nidx * 65536;
        const float* ng = (const float*)(ws + 7 * kMiB + 768 * 1024) + (size_t)nidx * 1024;
        const float* nsc = mod + ((size_t)((has_next ? nl : 0) * 24 + b) * 9 + nsub * 3 + 1) * 1024;
        const int col0 = u.pn * BM + wc * 32 + 8 * fq;
        f32x4 gv[2][2], hm[2][2];
#pragma unroll
        for (int bj = 0; bj < 2; ++bj)
#pragma unroll
            for (int n = 0; n < 2; ++n) {
                gv[bj][n] = *(const f32x4*)(gp + col0 + bj * HALF + n * 4) * coef;
                hm[bj][n] = *(const f32x4*)(ng + col0 + bj * HALF + n * 4) * (*(const f32x4*)(nsc + col0 + bj * HALF + n * 4) + 1.0f);
            }
        const float* base = fx ? ((r00 < 32768) ? xp : xs - (size_t)32768 * 1024) : out;
#pragma unroll
        for (int ai = 0; ai < 2; ++ai)
#pragma unroll
            for (int m = 0; m < 4; ++m) {
                const int row = r00 + ai * HALF + wr * 64 + m * 16 + fr;
                const size_t off = (size_t)row * 1024 + col0;
                float sq = 0.f;
#pragma unroll
                for (int bj = 0; bj < 2; ++bj) {
                    const f32x4 x0 = *(const f32x4*)(base + off + bj * HALF), x1 = *(const f32x4*)(base + off + bj * HALF + 4);
                    const f32x4 o0 = x0 + gv[bj][0] * acc[ai][bj][m][0], o1 = x1 + gv[bj][1] * acc[ai][bj][m][1];
                    *(f32x4*)(out + off + bj * HALF) = o0; *(f32x4*)(out + off + bj * HALF + 4) = o1;
                    if (has_next) {
                        sq += ((o0[0] * o0[0] + o0[1] * o0[1]) + (o0[2] * o0[2] + o0[3] * o0[3])) + ((o1[0] * o1[0] + o1[1] * o1[1]) + (o1[2] * o1[2] + o1[3] * o1[3]));
                        const f32x4 h0 = o0 * hm[bj][0], h1 = o1 * hm[bj][1];
                        u32x4 w; w.x = cvt_pk_bf16(h0[0], h0[1]); w.y = cvt_pk_bf16(h0[2], h0[3]); w.z = cvt_pk_bf16(h1[0], h1[1]); w.w = cvt_pk_bf16(h1[2], h1[3]);
                        *(u32x4*)(Hn + off + bj * HALF) = w;
                    }
                }
                if (has_next) {
                    sq += __shfl_xor(sq, 16); sq += __shfl_xor(sq, 32);
                    if (fq == 0) unsafeAtomicAdd(ssqn + row, sq);
                }
            }
    }
};
}

#define LAS __attribute__((address_space(3)))
typedef unsigned short bf16;
typedef unsigned u32x4 __attribute__((ext_vector_type(4)));
typedef unsigned u32x2 __attribute__((ext_vector_type(2)));
typedef float f32x4 __attribute__((ext_vector_type(4)));
constexpr int D = 1024, T = 65536, TP = 32768, FF = 2816, NPJ = 4096, DEPTH = 4, NB = 24;
constexpr int PJP = 4096 + 128;
constexpr float EPS = 1e-6f;
constexpr size_t MiB = 1u << 20;
constexpr size_t WS_CTL = 0, CTL_BYTES = 4 * MiB;
constexpr size_t WS_SSQ = 1 * MiB;
constexpr size_t WS_MOD = 4 * MiB;
constexpr size_t WS_NG = 7 * MiB + 768 * 1024;
constexpr size_t WS_SHW = 8 * MiB;
constexpr size_t WS_WGU0 = 16 * MiB, WS_WGU1 = 27 * MiB, WS_WD0 = 38 * MiB, WS_WD1 = 44 * MiB, WS_WIN = 50 * MiB, WS_WOUT = 58 * MiB;
constexpr size_t WS_H = 64 * MiB;
constexpr size_t WS_BIG = 192 * MiB;
constexpr size_t WS_H2 = 576 * MiB;
constexpr size_t WS_END = 720 * MiB;
constexpr int LDS_BYTES = 158720;
constexpr int NPHASE = 2 + 8 * DEPTH;

struct Params {
    const float *xp, *xs, *cp, *cs, *w_mod, *b_mod, *norm_g, *wg, *wu, *wd, *w_in, *w_out, *lbf, *lbb, *hgn, *qng, *kng, *rpb;
    float* out; unsigned char* ws;
    int ph_lo, ph_hi;
};

__device__ __forceinline__ unsigned f2bf(float f) { unsigned u = __builtin_bit_cast(unsigned, f); return (u + 0x7fffu + ((u >> 16) & 1u)) >> 16; }
typedef float f32x2_t __attribute__((ext_vector_type(2)));
typedef __bf16 bf16x2_t __attribute__((ext_vector_type(2)));
typedef short bf16x8 __attribute__((ext_vector_type(8)));
__device__ __forceinline__ unsigned pk2(float lo, float hi) { f32x2_t v = {lo, hi}; bf16x2_t r = __builtin_convertvector(v, bf16x2_t); return __builtin_bit_cast(unsigned, r); }
#define LBAR() do { asm volatile("s_waitcnt lgkmcnt(0)" ::: "memory"); __builtin_amdgcn_s_barrier(); asm volatile("" ::: "memory"); } while (0)
#define MFMA16(a, b, c) __builtin_amdgcn_mfma_f32_16x16x32_bf16((a), (b), (c), 0, 0, 0)
__device__ __forceinline__ float bflo(unsigned w) { return __uint_as_float(w << 16); }
__device__ __forceinline__ float bfhi(unsigned w) { return __uint_as_float(w & 0xffff0000u); }
__device__ __forceinline__ void unpack8(const u32x4 w, float (&f)[8]) {
    f[0] = bflo(w.x); f[1] = bfhi(w.x); f[2] = bflo(w.y); f[3] = bfhi(w.y); f[4] = bflo(w.z); f[5] = bfhi(w.z); f[6] = bflo(w.w); f[7] = bfhi(w.w);
}
__device__ __forceinline__ float wave_sum(float v) {
#pragma unroll
    for (int o = 1; o < 64; o <<= 1) v += __shfl_xor(v, o);
    return v;
}
__device__ __forceinline__ int batch_of_row(int row) { return row < TP ? (row >> 11) : 16 + ((row - TP) >> 12); }
__device__ __forceinline__ float silu(float g) { return g / (1.0f + __expf(-g)); }
__device__ __forceinline__ float sigm(float g) { return 1.0f / (1.0f + __expf(-g)); }

__device__ __forceinline__ void gemv24_item(const float* W, int N, int j0, LAS float* sc, LAS float* red, float (&res)[6], const int tid) {
    const int lane = tid & 63, wave = tid >> 6, cg = lane & 31, ks = wave * 2 + (lane >> 5);
    f32x4 acc[24];
#pragma unroll
    for (int b = 0; b < 24; ++b) acc[b] = (f32x4){0.f, 0.f, 0.f, 0.f};
    const float* w = W + (size_t)(ks * 64) * N + j0 + cg * 4;
#pragma unroll 8
    for (int kk = 0; kk < 64; ++kk) {
        const f32x4 wv = *(const f32x4*)(w + (size_t)kk * N);
        const LAS f32x4* s4 = (const LAS f32x4*)(sc + (ks * 64 + kk) * 24);
#pragma unroll
        for (int b4 = 0; b4 < 6; ++b4) { const f32x4 s = s4[b4]; acc[4 * b4] += wv * s[0]; acc[4 * b4 + 1] += wv * s[1]; acc[4 * b4 + 2] += wv * s[2]; acc[4 * b4 + 3] += wv * s[3]; }
    }
#pragma unroll
    for (int bg = 0; bg < 3; ++bg) {
#pragma unroll
        for (int bb = 0; bb < 8; ++bb) {
            f32x4 a = acc[8 * bg + bb];
            a[0] += __shfl_xor(a[0], 32); a[1] += __shfl_xor(a[1], 32); a[2] += __shfl_xor(a[2], 32); a[3] += __shfl_xor(a[3], 32);
            if (lane < 32) *(LAS f32x4*)(red + ((wave * 8 + bb) * 128 + cg * 4)) = a;
        }
        __syncthreads();
#pragma unroll
        for (int h = 0; h < 2; ++h) {
            const int bb = 4 * h + (tid >> 7), j = tid & 127;
            float s = 0.f;
#pragma unroll
            for (int wv = 0; wv < 8; ++wv) s += red[(wv * 8 + bb) * 128 + j];
            res[2 * bg + h] = s;
        }
        __syncthreads();
    }
}
__device__ __forceinline__ void phase_mod(const Params& p, LAS unsigned char* lds, const int tid) {
    LAS float* sc = (LAS float*)lds;
    LAS float* red = (LAS float*)(lds + 98304);
    float* mod = (float*)(p.ws + WS_MOD);
    for (int e = tid; e < 24 * 1024; e += 512) {
        const int b = e >> 10, k = e & 1023;
        const float c = b < 16 ? p.cp[b * 1024 + k] : p.cs[(b - 16) * 1024 + k];
        sc[k * 24 + b] = silu(c);
    }
    __syncthreads();
    for (int item = blockIdx.x; item < 288; item += gridDim.x) {
        const int l = item / 72, j0 = (item % 72) * 128;
        float res[6];
        gemv24_item(p.w_mod + (size_t)l * 1024 * 9216, 9216, j0, sc, red, res, tid);
#pragma unroll
        for (int i = 0; i < 6; ++i) { const int e = tid + 512 * i, b = e >> 7, j = e & 127; mod[((size_t)l * 24 + b) * 9216 + j0 + j] = res[i] + p.b_mod[l * 9216 + j0 + j]; }
    }
    __syncthreads();
}

__device__ __forceinline__ void phase_shw(const Params& p, LAS unsigned char* lds, const int tid) {
    LAS float* sc = (LAS float*)lds;
    LAS float* red = (LAS float*)(lds + 98304);
    const float* mod = (const float*)(p.ws + WS_MOD);
    float* shw = (float*)(p.ws + WS_SHW);
    int have = -1;
    for (int it = 0; it < 2 * ((480 + 2 * (int)gridDim.x - 1) / (2 * (int)gridDim.x)); ++it) {
        const int item = ((it >> 1) * (int)gridDim.x + (int)blockIdx.x) * 2 + (it & 1);
        if (item >= 480) continue;
        const int l = item / 120, r = item % 120;
        const int sub = r < 44 ? 0 : (r < 76 ? 1 : 2);
        const int mat = sub == 1 ? 2 : ((r < 22 || (r >= 76 && r < 98)) ? 0 : 1);
        const int blk = r < 22 ? r : (r < 44 ? r - 22 : (r < 76 ? r - 44 : (r < 98 ? r - 76 : r - 98)));
        const int ffn = sub == 2 ? 1 : 0;
        const int N = mat == 2 ? NPJ : FF;
        const size_t woff = mat == 2 ? (size_t)l * D * NPJ : (size_t)(l * 2 + ffn) * D * FF;
        const float* W = (mat == 2 ? p.w_in : (mat == 0 ? p.wg : p.wu)) + woff;
        const int j0 = blk * 128;
        const int d0 = mat == 2 ? j0 : (blk * 256 + (mat == 1 ? 128 : 0));
        if (have != l * 3 + sub) {
            __syncthreads();
            for (int e = tid; e < 24 * 1024; e += 512) {
                const int b = e >> 10, k = e & 1023;
                sc[k * 24 + b] = mod[((size_t)(l * 24 + b) * 9 + sub * 3) * D + k];
            }
            have = l * 3 + sub;
            __syncthreads();
        }
        float res[6];
        gemv24_item(W, N, j0, sc, red, res, tid);
#pragma unroll
        for (int i = 0; i < 6; ++i) { const int e = tid + 512 * i, b = e >> 7, j = e & 127; shw[((size_t)(l * 3 + sub) * 24 + b) * 5632 + d0 + j] = res[i]; }
    }
    __syncthreads();
}

template <int MODE>
__device__ __forceinline__ void transpose_item(const float* W, int K, int N, bf16* WT, LAS float* scr, int item, int lane) {
    const int nblk = N / 32, kb = item / nblk, nb = item % nblk, k0 = 64 * kb, n0 = 32 * nb;
    const int rbase = MODE == 0 ? n0 : ((n0 >> 7) * 256 + (n0 & 127) + (MODE == 2 ? 128 : 0));
    float wv_[32];
#pragma unroll
    for (int i = 0; i < 32; ++i) wv_[i] = W[(size_t)(k0 + 2 * i + (lane >> 5)) * N + n0 + (lane & 31)];
#pragma unroll
    for (int i = 0; i < 32; ++i) scr[(2 * i + (lane >> 5)) * 33 + (lane & 31)] = wv_[i];
    asm volatile("s_waitcnt lgkmcnt(0)" ::: "memory");
    const int c = lane & 7;
#pragma unroll
    for (int j = 0; j < 4; ++j) { const int n = (lane >> 3) + 8 * j; const LAS float* s = scr + (8 * c) * 33 + n;
        u32x4 o; o.x = pk2(s[0 * 33], s[1 * 33]); o.y = pk2(s[2 * 33], s[3 * 33]); o.z = pk2(s[4 * 33], s[5 * 33]); o.w = pk2(s[6 * 33], s[7 * 33]);
        *(u32x4*)(WT + (size_t)(rbase + n) * K + k0 + 8 * c) = o; }
    asm volatile("s_waitcnt lgkmcnt(0)" ::: "memory");
}
constexpr int I_G = 16 * 88, I_D = 44 * 32, I_IN = 16 * 128, I_OUT = 16 * 32;
constexpr int NW_A = 2 * I_G + I_D + I_IN, NW_B = I_OUT + 2 * I_G + I_D;
__device__ __forceinline__ void weights_item(const Params& p, int l, bool setB, int r, LAS float* scr, int lane) {
    const size_t fsz = (size_t)D * FF;
    if (!setB) {
        if (r < I_G) { transpose_item<1>(p.wg + (size_t)(l * 2 + 0) * fsz, D, FF, (bf16*)(p.ws + WS_WGU0), scr, r, lane); return; } r -= I_G;
        if (r < I_G) { transpose_item<2>(p.wu + (size_t)(l * 2 + 0) * fsz, D, FF, (bf16*)(p.ws + WS_WGU0), scr, r, lane); return; } r -= I_G;
        if (r < I_D) { transpose_item<0>(p.wd + (size_t)(l * 2 + 0) * fsz, FF, D, (bf16*)(p.ws + WS_WD0), scr, r, lane); return; } r -= I_D;
        transpose_item<0>(p.w_in + (size_t)l * D * NPJ, D, NPJ, (bf16*)(p.ws + WS_WIN), scr, r, lane);
    } else {
        if (r < I_OUT) { transpose_item<0>(p.w_out + (size_t)l * D * D, D, D, (bf16*)(p.ws + WS_WOUT), scr, r, lane); return; } r -= I_OUT;
        if (r < I_G) { transpose_item<1>(p.wg + (size_t)(l * 2 + 1) * fsz, D, FF, (bf16*)(p.ws + WS_WGU1), scr, r, lane); return; } r -= I_G;
        if (r < I_G) { transpose_item<2>(p.wu + (size_t)(l * 2 + 1) * fsz, D, FF, (bf16*)(p.ws + WS_WGU1), scr, r, lane); return; } r -= I_G;
        transpose_item<0>(p.wd + (size_t)(l * 2 + 1) * fsz, FF, D, (bf16*)(p.ws + WS_WD1), scr, r, lane);
    }
}
__device__ __forceinline__ void phase_weights_a0(const Params& p, LAS unsigned char* lds, const int tid) {
    const int wave = tid >> 6, lane = tid & 63;
    LAS float* scr = (LAS float*)(lds + wave * 16384);
    const int gw = blockIdx.x * 8 + wave, NGW = gridDim.x * 8;
    for (int it = gw; it < NW_A; it += NGW) weights_item(p, 0, false, it, scr, lane);
}

__device__ __forceinline__ void phase_norm_first(const Params& p, const int tid) {
    const int wave = tid >> 6, lane = tid & 63;
    const int gw = blockIdx.x * 8 + wave, NGW = gridDim.x * 8;
    const f32x4* g4 = (const f32x4*)(p.norm_g) + lane;
    const float* mod = (const float*)(p.ws + WS_MOD);
    bf16* H = (bf16*)(p.ws + WS_H);
    float* ssq = (float*)(p.ws + WS_SSQ);
    for (int row = gw; row < T; row += NGW) {
        const float* xr = row < TP ? p.xp + (size_t)row * D : p.xs + (size_t)(row - TP) * D;
        const int b = batch_of_row(row);
        const f32x4* sc4 = (const f32x4*)(mod + ((size_t)b * 9 + 1) * D) + lane;
        const f32x4* x4 = (const f32x4*)xr + lane;
        f32x4 v[4]; float s = 0.f;
#pragma unroll
        for (int j = 0; j < 4; ++j) { v[j] = x4[64 * j]; s += (v[j].x * v[j].x + v[j].y * v[j].y) + (v[j].z * v[j].z + v[j].w * v[j].w); }
        s = wave_sum(s);
        if (lane == 0) ssq[row] = s;
        u32x2* o8 = (u32x2*)(H + (size_t)row * D) + lane;
#pragma unroll
        for (int j = 0; j < 4; ++j) {
            const f32x4 y = v[j] * g4[64 * j] * (sc4[64 * j] + 1.0f);
            u32x2 w; w.x = pk2(y.x, y.y); w.y = pk2(y.z, y.w);
            o8[64 * j] = w;
        }
    }
}

__device__ __forceinline__ void hgrn_chain(const Params& p, int l, int ch, LAS unsigned char* lds, const int tid) {
    const int seq = ch >> 3, head = (ch >> 1) & 3, dir = ch & 1;
    const int tb = seq < 16 ? seq * 2048 : TP + (seq - 16) * 4096, L = seq < 16 ? 2048 : 4096;
    bf16* proj = (bf16*)(p.ws + WS_BIG);
    const int cq = head * 128, cf = 512 + dir * 512 + head * 128, ci = 1536 + head * 128;
    LAS float* qs = (LAS float*)lds; LAS float* fs = qs + 4096; LAS float* vs = fs + 4096; LAS float* po = vs + 4096;
    const int st = tid >> 4, c8 = (tid & 15) * 8;
    float lbv[8];
    {
        const float* raw = (dir ? p.lbb : p.lbf) + head * 128 + c8;
#pragma unroll
        for (int j = 0; j < 8; ++j) {
            const float a0 = raw[j], a1 = raw[512 + j], a2 = raw[1024 + j], a3 = raw[1536 + j];
            const float mx = fmaxf(fmaxf(a0, a1), fmaxf(a2, a3));
            const float e0 = __expf(a0 - mx), e1 = __expf(a1 - mx), e2 = __expf(a2 - mx), e3 = __expf(a3 - mx);
            const float z = (e0 + e1) + (e2 + e3);
            float num = 0.f; if (l >= 1) num += e1; if (l >= 2) num += e2; if (l >= 3) num += e3;
            lbv[j] = num / z;
        }
    }
    float S[32];
#pragma unroll
    for (int i = 0; i < 32; ++i) S[i] = 0.f;
    const int v = tid & 127, kq = tid >> 7;
    const int nch = L / 32;
    for (int c = 0; c < nch; ++c) {
        const int pos = c * 32 + st;
        const int tok = tb + (dir ? (L - 1 - pos) : pos);
        bf16* row = proj + (size_t)tok * PJP;
        {
            const u32x4 rq = *(const u32x4*)(row + cq + c8), rf = *(const u32x4*)(row + cf + c8), ri = *(const u32x4*)(row + ci + c8);
            float fq_[8], ff_[8], fi_[8]; unpack8(rq, fq_); unpack8(rf, ff_); unpack8(ri, fi_);
#pragma unroll
            for (int j = 0; j < 8; ++j) {
                qs[st * 128 + c8 + j] = silu(fq_[j]);
                fs[st * 128 + c8 + j] = lbv[j] + (1.0f - lbv[j]) * sigm(ff_[j]);
                vs[st * 128 + c8 + j] = fi_[j];
            }
        }
        __syncthreads();
        for (int t = 0; t < 32; ++t) {
            const float vv = vs[t * 128 + v];
            float o = 0.f;
            const LAS f32x4* f4 = (const LAS f32x4*)(fs + t * 128 + kq * 32);
            const LAS f32x4* q4 = (const LAS f32x4*)(qs + t * 128 + kq * 32);
#pragma unroll
            for (int i4 = 0; i4 < 8; ++i4) {
                const f32x4 f = f4[i4], q = q4[i4];
#pragma unroll
                for (int e = 0; e < 4; ++e) { S[4 * i4 + e] = vv + f[e] * (S[4 * i4 + e] - vv); o += S[4 * i4 + e] * q[e]; }
            }
            po[(t * 4 + kq) * 128 + v] = o;
        }
        __syncthreads();
        {
            float o[8];
#pragma unroll
            for (int j = 0; j < 8; ++j) o[j] = 0.f;
#pragma unroll
            for (int k4 = 0; k4 < 4; ++k4) {
                const LAS f32x4* s4 = (const LAS f32x4*)(po + (st * 4 + k4) * 128 + c8);
                const f32x4 a = s4[0], b = s4[1];
                o[0] += a[0]; o[1] += a[1]; o[2] += a[2]; o[3] += a[3]; o[4] += b[0]; o[5] += b[1]; o[6] += b[2]; o[7] += b[3];
            }
            u32x4 w; w.x = pk2(o[0], o[1]); w.y = pk2(o[2], o[3]); w.z = pk2(o[4], o[5]); w.w = pk2(o[6], o[7]);
            *(u32x4*)(row + cf + c8) = w;
        }
    }
    __syncthreads();
}


constexpr int HB_QB = 0, HB_QM = 8704, HB_KM = 17408, HB_KLT = 26112, HB_VT = 36352, HB_AM = 46592, HB_DEC = 49152, HB_TOT = 49664, HB_SIZE = 51712;
__device__ __forceinline__ void hgrn_chain_mfma(const Params& p, int l, int ch, LAS unsigned char* lds, const int tid) {
    const int seq = ch >> 3, head = (ch >> 1) & 3, dir = ch & 1;
    const int tb = seq < 16 ? seq * 2048 : TP + (seq - 16) * 4096, L = seq < 16 ? 2048 : 4096;
    bf16* proj = (bf16*)(p.ws + WS_BIG);
    const int cq = head * 128, cf = 512 + dir * 512 + head * 128, ci = 1536 + head * 128;
    const int k = tid & 127, tg = tid >> 7;
    const int lane = tid & 63, w = __builtin_amdgcn_readfirstlane(tid >> 6), r16 = lane & 15, g = lane >> 4;
    float lb;
    {
        const float* raw = (dir ? p.lbb : p.lbf) + head * 128 + k;
        const float a0 = raw[0], a1 = raw[512], a2 = raw[1024], a3 = raw[1536];
        const float mx = fmaxf(fmaxf(a0, a1), fmaxf(a2, a3));
        const float e0 = __expf(a0 - mx), e1 = __expf(a1 - mx), e2 = __expf(a2 - mx), e3 = __expf(a3 - mx);
        float num = 0.f; if (l >= 1) num += e1; if (l >= 2) num += e2; if (l >= 3) num += e3;
        lb = num / ((e0 + e1) + (e2 + e3));
    }
    const float oml = 1.0f - lb;
    f32x4 S[8];
#pragma unroll
    for (int t = 0; t < 8; ++t) S[t] = (f32x4){0.f, 0.f, 0.f, 0.f};
    unsigned rq[8], rf[8], ri[8];
    const int tstep = dir ? -PJP : PJP;
    const int nch = L / 32;
    float q[8], kk[8], bb[8], vv[8];
    unsigned voffL[8], voffS[8];
#pragma unroll
    for (int e = 0; e < 8; ++e) {
        const int rl = dir ? (31 - 8 * tg - e) : (8 * tg + e);
        voffL[e] = (unsigned)(rl * (PJP * 2) + k * 2);
        const int ps = 16 * (e >> 2) + 4 * g + (e & 3), rs_ = dir ? (31 - ps) : ps;
        voffS[e] = (unsigned)(rs_ * (PJP * 2) + (16 * w + r16) * 2);
    }
    const char* pbase = (const char*)proj + (size_t)tb * (PJP * 2);
#define HG_CBASE(cn) (pbase + (size_t)(dir ? (L - 32 * ((cn) + 1)) : 32 * (cn)) * (PJP * 2))
#define HG_LOAD(cn) do { const char* cb_ = HG_CBASE(cn); const char* bq_ = cb_ + cq * 2; const char* bf_ = cb_ + cf * 2; const char* bi_ = cb_ + ci * 2; \
        _Pragma("unroll") for (int e = 0; e < 8; ++e) { rq[e] = *(const unsigned short*)(bq_ + voffL[e]); rf[e] = *(const unsigned short*)(bf_ + voffL[e]); ri[e] = *(const unsigned short*)(bi_ + voffL[e]); } } while (0)
#define HG_P1(cn) do { LAS float* TOT_ = (LAS float*)(lds + ((cn) & 1) * HB_SIZE + HB_TOT); float run_ = 0.f; \
        _Pragma("unroll") for (int e = 0; e < 8; ++e) { const float hf_ = __uint_as_float(rf[e] << 16); q[e] = __uint_as_float(rq[e] << 16); vv[e] = __uint_as_float(ri[e] << 16); \
            const float f_ = lb + oml * hf_; run_ += fmaxf(__log2f(f_), -120.f); bb[e] = run_; kk[e] = 1.0f - f_; } \
        TOT_[tg * 128 + k] = run_; } while (0)
#define HG_P2(cn) do { LAS unsigned char* B_ = lds + ((cn) & 1) * HB_SIZE; \
        LAS bf16* QB_ = (LAS bf16*)(B_ + HB_QB); LAS bf16* QM_ = (LAS bf16*)(B_ + HB_QM); LAS bf16* KM_ = (LAS bf16*)(B_ + HB_KM); \
        LAS bf16* KLT_ = (LAS bf16*)(B_ + HB_KLT); LAS bf16* VT_ = (LAS bf16*)(B_ + HB_VT); LAS float* DEC_ = (LAS float*)(B_ + HB_DEC); LAS float* TOT_ = (LAS float*)(B_ + HB_TOT); \
        const float t0 = TOT_[k], t1 = TOT_[128 + k], t2 = TOT_[256 + k], t3 = TOT_[384 + k]; \
        const float off = tg == 0 ? 0.f : (tg == 1 ? t0 : (tg == 2 ? t0 + t1 : (t0 + t1) + t2)); \
        const float bm = t0 + t1, b31 = (t0 + t1) + (t2 + t3); \
        const float sbm = __builtin_amdgcn_exp2f(bm), s31 = __builtin_amdgcn_exp2f(b31 - bm); \
        float kl[8]; \
        _Pragma("unroll") for (int e = 0; e < 8; ++e) { const float b = off + bb[e]; const int i = 8 * tg + e; \
            const float qm = q[e] * __builtin_amdgcn_exp2f(fminf(b - bm, 100.f)); \
            const float km = kk[e] * __builtin_amdgcn_exp2f(fminf(bm - b, 100.f)); \
            QB_[i * 136 + k] = (bf16)(pk2(qm * sbm, 0.f) & 0xffffu); QM_[i * 136 + k] = (bf16)(pk2(qm, 0.f) & 0xffffu); KM_[i * 136 + k] = (bf16)(pk2(km, 0.f) & 0xffffu); \
            kl[e] = km * s31; } \
        u32x4 wk; wk.x = pk2(kl[0], kl[1]); wk.y = pk2(kl[2], kl[3]); wk.z = pk2(kl[4], kl[5]); wk.w = pk2(kl[6], kl[7]); \
        *(LAS u32x4*)(KLT_ + k * 40 + 8 * tg) = wk; \
        u32x4 wv; wv.x = pk2(vv[0], vv[1]); wv.y = pk2(vv[2], vv[3]); wv.z = pk2(vv[4], vv[5]); wv.w = pk2(vv[6], vv[7]); \
        *(LAS u32x4*)(VT_ + k * 40 + 8 * tg) = wv; \
        if (tg == 0) DEC_[k] = __builtin_amdgcn_exp2f(b31); } while (0)
    HG_LOAD(0);
    HG_P1(0);
    LBAR();
    HG_P2(0);
    HG_LOAD(1);
    HG_P1(1);
    LBAR();
    const int t4 = w & 3, sti = (t4 == 1 || t4 == 2) ? 1 : 0, stj = (t4 >= 2) ? 1 : 0;
    for (int c = 0; c < nch; ++c) {
        LAS unsigned char* B = lds + (c & 1) * HB_SIZE;
        LAS bf16* QB = (LAS bf16*)(B + HB_QB); LAS bf16* QM = (LAS bf16*)(B + HB_QM); LAS bf16* KM = (LAS bf16*)(B + HB_KM);
        LAS bf16* KLT = (LAS bf16*)(B + HB_KLT); LAS bf16* VT = (LAS bf16*)(B + HB_VT); LAS bf16* AM = (LAS bf16*)(B + HB_AM);
        LAS float* DEC = (LAS float*)(B + HB_DEC);
        const int cn = min(c + 1, nch - 1);
        HG_LOAD(min(c + 2, nch - 1));
        HG_P2(c + 1);
        {
            f32x4 sc = (f32x4){0.f, 0.f, 0.f, 0.f};
#pragma unroll
            for (int s = 0; s < 4; ++s) {
                const bf16x8 a = *(const LAS bf16x8*)(QM + (16 * sti + r16) * 136 + 32 * s + 8 * g);
                const bf16x8 b = *(const LAS bf16x8*)(KM + (16 * stj + r16) * 136 + 32 * s + 8 * g);
                sc = MFMA16(a, b, sc);
            }
#pragma unroll
            for (int r = 0; r < 4; ++r) {
                const int i = 16 * sti + 4 * g + r, j = 16 * stj + r16;
                const float val = (j <= i) ? sc[r] : 0.f;
                AM[i * 40 + j] = (bf16)(pk2(val, 0.f) & 0xffffu);
            }
        }
        f32x4 O[2];
        O[0] = (f32x4){0.f, 0.f, 0.f, 0.f}; O[1] = O[0];
#pragma unroll
        for (int s = 0; s < 4; ++s) {
            u32x4 bw; bw.x = pk2(S[2 * s][0], S[2 * s][1]); bw.y = pk2(S[2 * s][2], S[2 * s][3]); bw.z = pk2(S[2 * s + 1][0], S[2 * s + 1][1]); bw.w = pk2(S[2 * s + 1][2], S[2 * s + 1][3]);
            const bf16x8 bfrag = __builtin_bit_cast(bf16x8, bw);
#pragma unroll
            for (int ti = 0; ti < 2; ++ti) {
                const u32x2 lo = *(const LAS u32x2*)(QB + (16 * ti + r16) * 136 + 32 * s + 4 * g);
                const u32x2 hi = *(const LAS u32x2*)(QB + (16 * ti + r16) * 136 + 32 * s + 16 + 4 * g);
                u32x4 aw; aw.x = lo.x; aw.y = lo.y; aw.z = hi.x; aw.w = hi.y;
                O[ti] = MFMA16(__builtin_bit_cast(bf16x8, aw), bfrag, O[ti]);
            }
        }
        const bf16x8 vfrag = *(const LAS bf16x8*)(VT + (16 * w + r16) * 40 + 8 * g);
#pragma unroll
        for (int t = 0; t < 8; ++t) {
            const f32x4 d4 = *(const LAS f32x4*)(DEC + 16 * t + 4 * g);
            S[t] = S[t] * d4;
            const bf16x8 a = *(const LAS bf16x8*)(KLT + (16 * t + r16) * 40 + 8 * g);
            S[t] = MFMA16(a, vfrag, S[t]);
        }
        LBAR();
#pragma unroll
        for (int ti = 0; ti < 2; ++ti) {
            const bf16x8 a = *(const LAS bf16x8*)(AM + (16 * ti + r16) * 40 + 8 * g);
            O[ti] = MFMA16(a, vfrag, O[ti]);
        }
        {
            char* sb_ = (char*)HG_CBASE(c) + cf * 2;
#pragma unroll
            for (int ti = 0; ti < 2; ++ti)
#pragma unroll
                for (int r = 0; r < 4; ++r) *(unsigned short*)(sb_ + voffS[ti * 4 + r]) = (unsigned short)(pk2(O[ti][r], 0.f) & 0xffffu);
        }
        HG_P1(c + 2);
        LBAR();
        (void)cn;
    }
#undef HG_LOAD
#undef HG_CBASE
#undef HG_P1
#undef HG_P2
    __syncthreads();
}


__device__ __forceinline__ void hgrn_chain_ws(const Params& p, int l, int ch, LAS unsigned char* lds, const int tid) {
    const int seq = ch >> 3, head = (ch >> 1) & 3, dir = ch & 1;
    const int tb = seq < 16 ? seq * 2048 : TP + (seq - 16) * 4096, L = seq < 16 ? 2048 : 4096;
    bf16* proj = (bf16*)(p.ws + WS_BIG);
    const int cq = head * 128, cf = 512 + dir * 512 + head * 128, ci = 1536 + head * 128;
    const int lane = tid & 63, w = __builtin_amdgcn_readfirstlane(tid >> 6), r16 = lane & 15, g = lane >> 4;
    const int nch = L / 32;
    const char* pbase = (const char*)proj + (size_t)tb * (PJP * 2);
#define WS_CBASE(cn) (pbase + (size_t)(dir ? (L - 32 * ((cn) + 1)) : 32 * (cn)) * (PJP * 2))
    if (w < 4) {
        const int k = tid & 127, th = tid >> 7;
        float lb;
        {
            const float* raw = (dir ? p.lbb : p.lbf) + head * 128 + k;
            const float a0 = raw[0], a1 = raw[512], a2 = raw[1024], a3 = raw[1536];
            const float mx = fmaxf(fmaxf(a0, a1), fmaxf(a2, a3));
            const float e0 = __expf(a0 - mx), e1 = __expf(a1 - mx), e2 = __expf(a2 - mx), e3 = __expf(a3 - mx);
            float num = 0.f; if (l >= 1) num += e1; if (l >= 2) num += e2; if (l >= 3) num += e3;
            lb = num / ((e0 + e1) + (e2 + e3));
        }
        const float oml = 1.0f - lb;
        unsigned voffL[16];
#pragma unroll
        for (int e = 0; e < 16; ++e) { const int rl = dir ? (31 - 16 * th - e) : (16 * th + e); voffL[e] = (unsigned)(rl * (PJP * 2) + k * 2); }
        unsigned rq[16], rf[16], ri[16];
        float q[16], kk[16], bb[16]; unsigned vr[16];
#define WS_LOAD(cn) do { const char* cb_ = WS_CBASE(cn); const char* bq_ = cb_ + cq * 2; const char* bf_ = cb_ + cf * 2; const char* bi_ = cb_ + ci * 2; \
        _Pragma("unroll") for (int e = 0; e < 16; ++e) { rq[e] = *(const unsigned short*)(bq_ + voffL[e]); rf[e] = *(const unsigned short*)(bf_ + voffL[e]); ri[e] = *(const unsigned short*)(bi_ + voffL[e]); } } while (0)
#define WS_P1(cn) do { LAS float* TOT_ = (LAS float*)(lds + ((cn) & 1) * HB_SIZE + HB_TOT); float run_ = 0.f; \
        _Pragma("unroll") for (int e = 0; e < 16; ++e) { const float hf_ = __uint_as_float(rf[e] << 16); q[e] = __uint_as_float(rq[e] << 16); vr[e] = ri[e]; \
            const float f_ = lb + oml * hf_; run_ += fmaxf(__builtin_amdgcn_logf(f_), -7.9f);        bb[e] = run_; kk[e] = 1.0f - f_; } \
        TOT_[th * 128 + k] = run_; } while (0)
#define WS_P2(cn) do { LAS unsigned char* B_ = lds + ((cn) & 1) * HB_SIZE; \
        LAS bf16* QB_ = (LAS bf16*)(B_ + HB_QB); LAS bf16* QM_ = (LAS bf16*)(B_ + HB_QM); LAS bf16* KM_ = (LAS bf16*)(B_ + HB_KM); \
        LAS bf16* KLT_ = (LAS bf16*)(B_ + HB_KLT); LAS bf16* VT_ = (LAS bf16*)(B_ + HB_VT); LAS float* DEC_ = (LAS float*)(B_ + HB_DEC); LAS float* TOT_ = (LAS float*)(B_ + HB_TOT); \
        const float t0 = TOT_[k], t1 = TOT_[128 + k]; \
        const float off = th == 0 ? 0.f : t0; \
        const float bm = t0, b31 = t0 + t1;                                 \
        const float sbm = __builtin_amdgcn_exp2f(bm), s31 = __builtin_amdgcn_exp2f(b31 - bm); \
        float kl[16]; \
        _Pragma("unroll") for (int e = 0; e < 16; e += 2) { const int i = 16 * th + e; \
            const float d0_ = off + bb[e] - bm, d1_ = off + bb[e + 1] - bm; \
            const float qm0 = q[e] * __builtin_amdgcn_exp2f(d0_), qm1 = q[e + 1] * __builtin_amdgcn_exp2f(d1_); \
            const float km0 = kk[e] * __builtin_amdgcn_exp2f(-d0_), km1 = kk[e + 1] * __builtin_amdgcn_exp2f(-d1_); \
            const unsigned wq_ = pk2(qm0, qm1), wk_ = pk2(km0, km1);            \
            QM_[i * 136 + k] = (bf16)(wq_ & 0xffffu); QM_[(i + 1) * 136 + k] = (bf16)(wq_ >> 16); \
            KM_[i * 136 + k] = (bf16)(wk_ & 0xffffu); KM_[(i + 1) * 136 + k] = (bf16)(wk_ >> 16); \
            kl[e] = km0 * s31; kl[e + 1] = km1 * s31; } \
        _Pragma("unroll") for (int h8 = 0; h8 < 2; ++h8) { \
            u32x4 wk; wk.x = pk2(kl[8 * h8 + 0], kl[8 * h8 + 1]); wk.y = pk2(kl[8 * h8 + 2], kl[8 * h8 + 3]); wk.z = pk2(kl[8 * h8 + 4], kl[8 * h8 + 5]); wk.w = pk2(kl[8 * h8 + 6], kl[8 * h8 + 7]); \
            *(LAS u32x4*)(KLT_ + k * 40 + 16 * th + 8 * h8) = wk; \
            u32x4 wv; wv.x = vr[8 * h8 + 0] | (vr[8 * h8 + 1] << 16); wv.y = vr[8 * h8 + 2] | (vr[8 * h8 + 3] << 16); wv.z = vr[8 * h8 + 4] | (vr[8 * h8 + 5] << 16); wv.w = vr[8 * h8 + 6] | (vr[8 * h8 + 7] << 16); \
            *(LAS u32x4*)(VT_ + k * 40 + 16 * th + 8 * h8) = wv; } \
        if (th == 0) { DEC_[k] = __builtin_amdgcn_exp2f(b31); ((LAS float*)(B_ + HB_QB))[k] = sbm; } } while (0)
        WS_LOAD(0);
        WS_P1(0);
        LBAR();
        WS_P2(0);
        WS_LOAD(1);
        WS_P1(1);
        LBAR();
        for (int c = 0; c < nch; ++c) {
            WS_LOAD(min(c + 2, nch - 1));
            WS_P2(c + 1);
            LBAR();
            WS_P1(c + 2);
            LBAR();
        }
#undef WS_LOAD
#undef WS_P1
#undef WS_P2
    } else {
        const int mw = w - 4;
        f32x4 S[8][2];
#pragma unroll
        for (int t = 0; t < 8; ++t) { S[t][0] = (f32x4){0.f, 0.f, 0.f, 0.f}; S[t][1] = S[t][0]; }
        unsigned voffS[2][8];
#pragma unroll
        for (int vt = 0; vt < 2; ++vt)
#pragma unroll
            for (int e = 0; e < 8; ++e) { const int ps = 16 * (e >> 2) + 4 * g + (e & 3), rs_ = dir ? (31 - ps) : ps; voffS[vt][e] = (unsigned)(rs_ * (PJP * 2) + (16 * (2 * mw + vt) + r16) * 2); }
        const int sti = (mw == 1 || mw == 2) ? 1 : 0, stj = (mw >= 2) ? 1 : 0;
        LBAR();
        LBAR();
        for (int c = 0; c < nch; ++c) {
            LAS unsigned char* B = lds + (c & 1) * HB_SIZE;
            LAS bf16* QB = (LAS bf16*)(B + HB_QB); LAS bf16* QM = (LAS bf16*)(B + HB_QM); LAS bf16* KM = (LAS bf16*)(B + HB_KM);
            LAS bf16* KLT = (LAS bf16*)(B + HB_KLT); LAS bf16* VT = (LAS bf16*)(B + HB_VT); LAS bf16* AM = (LAS bf16*)(B + HB_AM);
            LAS float* DEC = (LAS float*)(B + HB_DEC); LAS float* SBM = (LAS float*)(B + HB_QB);
            {
                f32x4 sc = (f32x4){0.f, 0.f, 0.f, 0.f};
#pragma unroll
                for (int s = 0; s < 4; ++s) {
                    const bf16x8 a = *(const LAS bf16x8*)(QM + (16 * sti + r16) * 136 + 32 * s + 8 * g);
                    const bf16x8 b = *(const LAS bf16x8*)(KM + (16 * stj + r16) * 136 + 32 * s + 8 * g);
                    sc = MFMA16(a, b, sc);
                }
#pragma unroll
                for (int r = 0; r < 4; ++r) {
                    const int i = 16 * sti + 4 * g + r, j = 16 * stj + r16;
                    const float val = (j <= i) ? sc[r] : 0.f;
                    AM[i * 40 + j] = (bf16)(pk2(val, 0.f) & 0xffffu);
                }
            }
            f32x4 O[2][2];
#pragma unroll
            for (int ti = 0; ti < 2; ++ti) { O[ti][0] = (f32x4){0.f, 0.f, 0.f, 0.f}; O[ti][1] = O[ti][0]; }
#pragma unroll
            for (int s = 0; s < 4; ++s) {
                bf16x8 bfrag[2];
                const f32x4 m0 = *(const LAS f32x4*)(SBM + 32 * s + 4 * g), m1 = *(const LAS f32x4*)(SBM + 32 * s + 16 + 4 * g);
#pragma unroll
                for (int vt = 0; vt < 2; ++vt) {
                    const f32x4 s0 = S[2 * s][vt] * m0, s1 = S[2 * s + 1][vt] * m1;
                    u32x4 bw; bw.x = pk2(s0[0], s0[1]); bw.y = pk2(s0[2], s0[3]); bw.z = pk2(s1[0], s1[1]); bw.w = pk2(s1[2], s1[3]);
                    bfrag[vt] = __builtin_bit_cast(bf16x8, bw);
                }
#pragma unroll
                for (int ti = 0; ti < 2; ++ti) {
                    const u32x2 lo = *(const LAS u32x2*)(QM + (16 * ti + r16) * 136 + 32 * s + 4 * g);
                    const u32x2 hi = *(const LAS u32x2*)(QM + (16 * ti + r16) * 136 + 32 * s + 16 + 4 * g);
                    u32x4 aw; aw.x = lo.x; aw.y = lo.y; aw.z = hi.x; aw.w = hi.y;
                    const bf16x8 af = __builtin_bit_cast(bf16x8, aw);
                    O[ti][0] = MFMA16(af, bfrag[0], O[ti][0]);
                    O[ti][1] = MFMA16(af, bfrag[1], O[ti][1]);
                }
            }
            bf16x8 vfrag[2];
#pragma unroll
            for (int vt = 0; vt < 2; ++vt) vfrag[vt] = *(const LAS bf16x8*)(VT + (16 * (2 * mw + vt) + r16) * 40 + 8 * g);
#pragma unroll
            for (int t = 0; t < 8; ++t) {
                const f32x4 d4 = *(const LAS f32x4*)(DEC + 16 * t + 4 * g);
                const bf16x8 a = *(const LAS bf16x8*)(KLT + (16 * t + r16) * 40 + 8 * g);
                S[t][0] = MFMA16(a, vfrag[0], S[t][0] * d4);
                S[t][1] = MFMA16(a, vfrag[1], S[t][1] * d4);
            }
            LBAR();
#pragma unroll
            for (int ti = 0; ti < 2; ++ti) {
                const bf16x8 a = *(const LAS bf16x8*)(AM + (16 * ti + r16) * 40 + 8 * g);
                O[ti][0] = MFMA16(a, vfrag[0], O[ti][0]);
                O[ti][1] = MFMA16(a, vfrag[1], O[ti][1]);
            }
            {
                char* sb_ = (char*)WS_CBASE(c) + cf * 2;
#pragma unroll
                for (int vt = 0; vt < 2; ++vt)
#pragma unroll
                    for (int ti = 0; ti < 2; ++ti)
#pragma unroll
                        for (int r = 0; r < 4; ++r) *(unsigned short*)(sb_ + voffS[vt][ti * 4 + r]) = (unsigned short)(pk2(O[ti][vt][r], 0.f) & 0xffffu);
            }
            LBAR();
        }
    }
#undef WS_CBASE
    __syncthreads();
}

__device__ __forceinline__ void na_unit(const Params& p, int l, int unit, LAS unsigned char* lds, const int tid) {
    const int h = unit & 7, rg = unit >> 3, tok0 = rg * 64;
    int rows, seqbase;
    if (tok0 < TP) { rows = 32; seqbase = tok0 & ~2047; } else { rows = 64; seqbase = TP + ((tok0 - TP) & ~4095); }
    const int r = (tok0 - seqbase) >> 6;
    const int r0 = min(max(r - 4, 0), rows - 8);
    const int qc = tid >> 3, j = tid & 7;
    const int c0 = min(max(qc - 8, 0), 48);
    const int kr = r0 + j;
    const bf16* proj = (const bf16*)(p.ws + WS_BIG);
    bf16* mix = (bf16*)(p.ws + WS_H);
    float qt[64];
    {
        const bf16* qrow = proj + (size_t)(tok0 + qc) * PJP + 2560 + h * 64;
        float ss = 0.f;
#pragma unroll
        for (int i = 0; i < 8; ++i) { float f[8]; unpack8(*(const u32x4*)(qrow + 8 * i), f);
#pragma unroll
            for (int e = 0; e < 8; ++e) { qt[8 * i + e] = f[e]; ss += f[e] * f[e]; } }
        const float rq = 0.125f / sqrtf(ss * (1.f / 64.f) + EPS);
        const float* gq = p.qng + l * 64; const float* gk = p.kng + l * 64;
#pragma unroll
        for (int d = 0; d < 64; ++d) qt[d] *= rq * gq[d] * gk[d];
    }
    const float* rpb_h = p.rpb + ((size_t)(l * 8 + h) * 15 + (kr - r + 7)) * 31;
    const bf16* krow0 = proj + (size_t)(seqbase + kr * 64 + c0) * PJP + 3072 + h * 64;
    LAS float* sb = (LAS float*)lds + tid;
    float m = -3.0e38f;
#pragma unroll 2
    for (int kk = 0; kk < 16; ++kk) {
        const bf16* krow = krow0 + (size_t)kk * PJP;
        float dot = 0.f, ss = 0.f;
#pragma unroll
        for (int i = 0; i < 8; ++i) { float f[8]; unpack8(*(const u32x4*)(krow + 8 * i), f);
#pragma unroll
            for (int e = 0; e < 8; ++e) { dot += qt[8 * i + e] * f[e]; ss += f[e] * f[e]; } }
        const int rel = min(max(c0 + kk - qc, -15), 15) + 15;
        const float sv = dot / sqrtf(ss * (1.f / 64.f) + EPS) + rpb_h[rel];
        sb[kk * 512] = sv; m = fmaxf(m, sv);
    }
    m = fmaxf(m, __shfl_xor(m, 1)); m = fmaxf(m, __shfl_xor(m, 2)); m = fmaxf(m, __shfl_xor(m, 4));
    float lsum = 0.f;
    float o[64];
#pragma unroll
    for (int d = 0; d < 64; ++d) o[d] = 0.f;
    const bf16* vrow0 = krow0 + 512;
#pragma unroll 2
    for (int kk = 0; kk < 16; ++kk) {
        const bf16* vrow = vrow0 + (size_t)kk * PJP;
        const float pk = __expf(sb[kk * 512] - m); lsum += pk;
#pragma unroll
        for (int i = 0; i < 8; ++i) { float f[8]; unpack8(*(const u32x4*)(vrow + 8 * i), f);
#pragma unroll
            for (int e = 0; e < 8; ++e) o[8 * i + e] += pk * f[e]; }
    }
    lsum += __shfl_xor(lsum, 1); lsum += __shfl_xor(lsum, 2); lsum += __shfl_xor(lsum, 4);
    const bool b2 = (j & 4) != 0, b1 = (j & 2) != 0, b0 = (j & 1) != 0;
    float o32[32], o16[16], o8[8];
#pragma unroll
    for (int i = 0; i < 32; ++i) { const float keep = b2 ? o[32 + i] : o[i], send = b2 ? o[i] : o[32 + i]; o32[i] = keep + __shfl_xor(send, 4); }
#pragma unroll
    for (int i = 0; i < 16; ++i) { const float keep = b1 ? o32[16 + i] : o32[i], send = b1 ? o32[i] : o32[16 + i]; o16[i] = keep + __shfl_xor(send, 2); }
#pragma unroll
    for (int i = 0; i < 8; ++i) { const float keep = b0 ? o16[8 + i] : o16[i], send = b0 ? o16[i] : o16[8 + i]; o8[i] = keep + __shfl_xor(send, 1); }
    const float inv = 1.0f / lsum;
    u32x4 w; w.x = pk2(o8[0] * inv, o8[1] * inv); w.y = pk2(o8[2] * inv, o8[3] * inv); w.z = pk2(o8[4] * inv, o8[5] * inv); w.w = pk2(o8[6] * inv, o8[7] * inv);
    *(u32x4*)(mix + (size_t)(tok0 + qc) * D + 512 + h * 64 + 8 * j) = w;
}


constexpr int NA_KS = 0, NA_VT = 73728, NA_RK = 140288, NA_RPB = 142336, NA_END = 144256, NA_XCH = NA_END + 1024;
__device__ __forceinline__ void na_stage_store(const u32x4 kw, const u32x4 vw, int kr, LAS unsigned char* lds, const int tid) {
    const int key = tid >> 3, ch = tid & 7, slot = kr & 7;
    float f[8]; unpack8(kw, f);
    float ss = 0.f;
#pragma unroll
    for (int e = 0; e < 8; ++e) ss += f[e] * f[e];
    ss += __shfl_xor(ss, 1); ss += __shfl_xor(ss, 2); ss += __shfl_xor(ss, 4);
    *(LAS u32x4*)((LAS bf16*)(lds + NA_KS) + (slot * 64 + key) * 72 + ch * 8) = kw;
    if (ch == 0) ((LAS float*)(lds + NA_RK))[slot * 64 + key] = __builtin_amdgcn_rsqf(ss * (1.f / 64.f) + EPS);
    LAS bf16* vt = (LAS bf16*)(lds + NA_VT) + (ch * 8) * 520 + slot * 64 + key;
    vt[0 * 520] = (bf16)(vw.x & 0xffffu); vt[1 * 520] = (bf16)(vw.x >> 16); vt[2 * 520] = (bf16)(vw.y & 0xffffu); vt[3 * 520] = (bf16)(vw.y >> 16);
    vt[4 * 520] = (bf16)(vw.z & 0xffffu); vt[5 * 520] = (bf16)(vw.z >> 16); vt[6 * 520] = (bf16)(vw.w & 0xffffu); vt[7 * 520] = (bf16)(vw.w >> 16);
}
__device__ __forceinline__ void na_unit_mfma(const Params& p, int l, int unit, LAS unsigned char* lds, const int tid) {
    int seq, h, run, rows, seqbase;
    if (unit < 512) { seq = unit >> 5; h = (unit >> 2) & 7; run = unit & 3; rows = 32; seqbase = seq * 2048; }
    else { const int u2 = unit - 512; seq = u2 >> 6; h = (u2 >> 3) & 7; run = u2 & 7; rows = 64; seqbase = TP + seq * 4096; }
    const bf16* proj = (const bf16*)(p.ws + WS_BIG);
    bf16* mix = (bf16*)(p.ws + WS_H);
    const int lane = tid & 63, w = __builtin_amdgcn_readfirstlane(tid >> 6), r16 = lane & 15, g = lane >> 4;
    const int jq = w & 3, hh = w >> 2;
    const int qc = 16 * jq + r16;
    const int kc0 = min(max(16 * jq - 8, 0), 32);
    const int c0 = min(max(qc - 8, 0), 48);
    LAS float* RPB = (LAS float*)(lds + NA_RPB);
    LAS float* RK = (LAS float*)(lds + NA_RK);
    LAS bf16* KS = (LAS bf16*)(lds + NA_KS);
    LAS bf16* VTS = (LAS bf16*)(lds + NA_VT);
    __syncthreads();
    if (tid < 465) RPB[tid] = p.rpb[(size_t)(l * 8 + h) * 465 + tid];
    LAS float* GQK = (LAS float*)(lds + NA_END + 256);
    if (tid < 64) GQK[tid] = p.qng[l * 64 + tid] * p.kng[l * 64 + tid];
    int bidx[8]; unsigned vmask = 0u;
#pragma unroll
    for (int ce = 0; ce < 8; ++ce) {
        const int kc = kc0 + 16 * (ce >> 2) + 4 * g + (ce & 3);
        bidx[ce] = min(max(kc, qc - 15), qc + 15);
        if (kc >= c0 && kc < c0 + 16) vmask |= 1u << ce;
    }
    const bf16* src0 = proj + (size_t)(seqbase + (tid >> 3)) * PJP + 3072 + h * 64 + (tid & 7) * 8;
    const bf16* qsrc0 = proj + (size_t)(seqbase + qc) * PJP + 2560 + h * 64 + 8 * g;
    int staged_hi;
    u32x4 qa, qb, nkw, nvw;
    {
        const int r = run * 8, r0 = min(max(r - 4, 0), rows - 8);
        u32x4 kw[8], vw[8];
#pragma unroll
        for (int i = 0; i < 8; ++i) { const bf16* s_ = src0 + (size_t)(r0 + i) * 64 * PJP; kw[i] = *(const u32x4*)s_; vw[i] = *(const u32x4*)(s_ + 512); }
        qa = *(const u32x4*)(qsrc0 + (size_t)r * 64 * PJP); qb = *(const u32x4*)(qsrc0 + (size_t)r * 64 * PJP + 32);
        __syncthreads();
#pragma unroll
        for (int i = 0; i < 8; ++i) na_stage_store(kw[i], vw[i], r0 + i, lds, tid);
        staged_hi = r0 + 7;
        nkw = kw[0]; nvw = vw[0];
    }
    for (int rq = 0; rq < 8; ++rq) {
        const int r = run * 8 + rq;
        const int r0 = min(max(r - 4, 0), rows - 8);
        LBAR();
        if (r0 + 7 > staged_hi) { na_stage_store(nkw, nvw, r0 + 7, lds, tid); staged_hi = r0 + 7; }
        const int tokq = seqbase + r * 64 + qc;
        bf16x8 qfrag[2];
        {
            float q0[8], q1[8]; unpack8(qa, q0); unpack8(qb, q1);
            float ss = 0.f;
#pragma unroll
            for (int e = 0; e < 8; ++e) ss += q0[e] * q0[e] + q1[e] * q1[e];
            ss += __shfl_xor(ss, 16); ss += __shfl_xor(ss, 32);
            const float rs = 0.125f * __builtin_amdgcn_rsqf(ss * (1.f / 64.f) + EPS);
            float gqk[2][8];
#pragma unroll
            for (int s = 0; s < 2; ++s) { const f32x4 ga = *(const LAS f32x4*)(GQK + 32 * s + 8 * g), gb = *(const LAS f32x4*)(GQK + 32 * s + 8 * g + 4);
                gqk[s][0] = ga[0]; gqk[s][1] = ga[1]; gqk[s][2] = ga[2]; gqk[s][3] = ga[3]; gqk[s][4] = gb[0]; gqk[s][5] = gb[1]; gqk[s][6] = gb[2]; gqk[s][7] = gb[3]; }
            u32x4 a, b;
            a.x = pk2(q0[0] * rs * gqk[0][0], q0[1] * rs * gqk[0][1]); a.y = pk2(q0[2] * rs * gqk[0][2], q0[3] * rs * gqk[0][3]);
            a.z = pk2(q0[4] * rs * gqk[0][4], q0[5] * rs * gqk[0][5]); a.w = pk2(q0[6] * rs * gqk[0][6], q0[7] * rs * gqk[0][7]);
            b.x = pk2(q1[0] * rs * gqk[1][0], q1[1] * rs * gqk[1][1]); b.y = pk2(q1[2] * rs * gqk[1][2], q1[3] * rs * gqk[1][3]);
            b.z = pk2(q1[4] * rs * gqk[1][4], q1[5] * rs * gqk[1][5]); b.w = pk2(q1[6] * rs * gqk[1][6], q1[7] * rs * gqk[1][7]);
            qfrag[0] = __builtin_bit_cast(bf16x8, a); qfrag[1] = __builtin_bit_cast(bf16x8, b);
        }
        LBAR();
        if (rq < 7) {
            const int rn = r + 1, r0n = min(max(rn - 4, 0), rows - 8);
            qa = *(const u32x4*)(qsrc0 + (size_t)rn * 64 * PJP); qb = *(const u32x4*)(qsrc0 + (size_t)rn * 64 * PJP + 32);
            if (r0n + 7 > staged_hi) { const bf16* s_ = src0 + (size_t)(r0n + 7) * 64 * PJP; nkw = *(const u32x4*)s_; nvw = *(const u32x4*)(s_ + 512); }
        }
        f32x4 sc[8];
        float m = -3.0e38f;
#pragma unroll
        for (int r4 = 0; r4 < 4; ++r4) {
            const int rr = 4 * hh + r4;
            const int slot = (r0 + rr) & 7;
            const LAS float* brow = RPB + (r0 + rr - r + 7) * 31 + 15 - qc;
            float bias[8];
#pragma unroll
            for (int ce = 0; ce < 8; ++ce) bias[ce] = brow[bidx[ce]];
#pragma unroll
            for (int ct = 0; ct < 2; ++ct) {
                f32x4 acc = (f32x4){0.f, 0.f, 0.f, 0.f};
                const LAS bf16* kp = KS + (slot * 64 + kc0 + 16 * ct + r16) * 72 + 8 * g;
                acc = MFMA16(*(const LAS bf16x8*)kp, qfrag[0], acc);
                acc = MFMA16(*(const LAS bf16x8*)(kp + 32), qfrag[1], acc);
                const f32x4 rk4 = *(const LAS f32x4*)(RK + slot * 64 + kc0 + 16 * ct + 4 * g);
#pragma unroll
                for (int e = 0; e < 4; ++e) {
                    const float v0 = acc[e] * rk4[e] + bias[ct * 4 + e];
                    const float v = ((vmask >> (ct * 4 + e)) & 1u) ? v0 : -3.0e38f;
                    acc[e] = v; m = fmaxf(m, v);
                }
                sc[r4 * 2 + ct] = acc;
            }
        }
        m = fmaxf(m, __shfl_xor(m, 16)); m = fmaxf(m, __shfl_xor(m, 32));
        float lsum = 0.f;
#pragma unroll
        for (int t = 0; t < 8; ++t)
#pragma unroll
            for (int e = 0; e < 4; ++e) { const float pv = __expf(sc[t][e] - m); sc[t][e] = pv; lsum += pv; }
        lsum += __shfl_xor(lsum, 16); lsum += __shfl_xor(lsum, 32);
        f32x4 O[4];
#pragma unroll
        for (int dt = 0; dt < 4; ++dt) O[dt] = (f32x4){0.f, 0.f, 0.f, 0.f};
#pragma unroll
        for (int r4 = 0; r4 < 4; ++r4) {
            const int slot = (r0 + 4 * hh + r4) & 7;
            u32x4 bw; bw.x = pk2(sc[2 * r4][0], sc[2 * r4][1]); bw.y = pk2(sc[2 * r4][2], sc[2 * r4][3]); bw.z = pk2(sc[2 * r4 + 1][0], sc[2 * r4 + 1][1]); bw.w = pk2(sc[2 * r4 + 1][2], sc[2 * r4 + 1][3]);
            const bf16x8 bfrag = __builtin_bit_cast(bf16x8, bw);
#pragma unroll
            for (int dt = 0; dt < 4; ++dt) {
                const LAS bf16* vp = VTS + (16 * dt + r16) * 520 + slot * 64 + kc0 + 4 * g;
                const u32x2 lo = *(const LAS u32x2*)vp, hi = *(const LAS u32x2*)(vp + 16);
                u32x4 aw; aw.x = lo.x; aw.y = lo.y; aw.z = hi.x; aw.w = hi.y;
                O[dt] = MFMA16(__builtin_bit_cast(bf16x8, aw), bfrag, O[dt]);
            }
        }
        LAS unsigned* X = (LAS unsigned*)(lds + NA_XCH) + jq * 64 + lane;
        if (hh == 1) {
            X[0 * 256] = __float_as_uint(m); X[1 * 256] = __float_as_uint(lsum);
#pragma unroll
            for (int dt = 0; dt < 4; ++dt) { X[(2 + 2 * dt) * 256] = pk2(O[dt][0], O[dt][1]); X[(3 + 2 * dt) * 256] = pk2(O[dt][2], O[dt][3]); }
        }
        LBAR();
        if (hh == 0) {
            const float m1 = __uint_as_float(X[0 * 256]), l1 = __uint_as_float(X[1 * 256]);
            const float mm = fmaxf(m, m1), a0 = __expf(m - mm), a1 = __expf(m1 - mm);
            const float inv = __builtin_amdgcn_rcpf(lsum * a0 + l1 * a1);
            const float c0_ = a0 * inv, c1_ = a1 * inv;
#pragma unroll
            for (int dt = 0; dt < 4; ++dt) {
                const unsigned w0 = X[(2 + 2 * dt) * 256], w1 = X[(3 + 2 * dt) * 256];
                u32x2 ow;
                ow.x = pk2(O[dt][0] * c0_ + bflo(w0) * c1_, O[dt][1] * c0_ + bfhi(w0) * c1_);
                ow.y = pk2(O[dt][2] * c0_ + bflo(w1) * c1_, O[dt][3] * c0_ + bfhi(w1) * c1_);
                *(u32x2*)(mix + (size_t)tokq * D + 512 + h * 64 + 16 * dt + 4 * g) = ow;
            }
        }
    }
}

__device__ __forceinline__ void phase_mixer(const Params& p, int l, LAS unsigned char* lds, const int tid) {
    if (blockIdx.x < 192) hgrn_chain_ws(p, l, blockIdx.x, lds, tid);
    unsigned* ctr = (unsigned*)(p.ws + WS_CTL) + 64 * (l + 1);
    LAS unsigned* sh = (LAS unsigned*)(lds + NA_END);
    const int nwi = NW_B + (l + 1 < DEPTH ? NW_A : 0);
    const unsigned nunits = 1024u + (unsigned)((nwi + 7) / 8);
    for (;;) {
        if (tid == 0) sh[0] = atomicAdd(ctr, 1u);
        __syncthreads();
        const unsigned u = sh[0];
        __syncthreads();
        if (u >= nunits) break;
        if (u < 1024u) na_unit_mfma(p, l, (int)u, lds, tid);
        else {
            const int wave = tid >> 6, lane = tid & 63;
            const int item = (int)(u - 1024u) * 8 + wave;
            LAS float* scr = (LAS float*)(lds + wave * 16384);
            if (item < NW_B) weights_item(p, l, true, item, scr, lane);
            else if (item < nwi) weights_item(p, l + 1, false, item - NW_B, scr, lane);
        }
    }
}

__device__ __forceinline__ void phase_combine(const Params& p, int l, const int tid) {
    const int wave = tid >> 6, lane = tid & 63;
    const int gw = blockIdx.x * 8 + wave, NGW = gridDim.x * 8;
    const bf16* proj = (const bf16*)(p.ws + WS_BIG);
    bf16* mix = (bf16*)(p.ws + WS_H);
    const int col = (lane >> 4) * 128 + (lane & 15) * 8;
    float g[8];
#pragma unroll
    for (int j = 0; j < 8; ++j) g[j] = p.hgn[l * 128 + (lane & 15) * 8 + j];
    for (int tok = gw; tok < T; tok += NGW) {
        const bf16* row = proj + (size_t)tok * PJP;
        float a[8], b[8], hg[8];
        unpack8(*(const u32x4*)(row + 512 + col), a); unpack8(*(const u32x4*)(row + 1024 + col), b); unpack8(*(const u32x4*)(row + 2048 + col), hg);
        float ss = 0.f;
#pragma unroll
        for (int j = 0; j < 8; ++j) { a[j] += b[j]; ss += a[j] * a[j]; }
        ss += __shfl_xor(ss, 1); ss += __shfl_xor(ss, 2); ss += __shfl_xor(ss, 4); ss += __shfl_xor(ss, 8);
        const float rstd = __builtin_amdgcn_rsqf(ss * (1.f / 128.f) + EPS);
        float y[8];
#pragma unroll
        for (int j = 0; j < 8; ++j) y[j] = a[j] * rstd * g[j] * hg[j];
        u32x4 w; w.x = pk2(y[0], y[1]); w.y = pk2(y[2], y[3]); w.z = pk2(y[4], y[5]); w.w = pk2(y[6], y[7]);
        *(u32x4*)(mix + (size_t)tok * D + col) = w;
    }
}

#define RLX_AGENT __ATOMIC_RELAXED, __HIP_MEMORY_SCOPE_AGENT
constexpr int CW_BAR = 4096;
#define XB_TMO      128
#define XB_XCNT(j)  (256  + 64 * (j))
#define XB_XSUB(j)  (1280 + 64 * (j))
#define XB_XGEN(j)  (2304 + 64 * (j))
#define XB_TOP      3328
#define XB_TOPGEN   3392
#define XCD_BAR_WORDS 3456
#define XB_SPIN_CAP (1u << 18)

__device__ __forceinline__ unsigned xb_ld(unsigned* p)              { return __hip_atomic_load(p, __ATOMIC_RELAXED, __HIP_MEMORY_SCOPE_AGENT); }
__device__ __forceinline__ unsigned xb_add(unsigned* p, unsigned v) { return __hip_atomic_fetch_add(p, v, __ATOMIC_RELAXED, __HIP_MEMORY_SCOPE_AGENT); }
__device__ __forceinline__ unsigned xb_xcc_id() { return (unsigned)__builtin_amdgcn_s_getreg((3 << 11) | 20) & 0xFu; }
#define XB_SPIN(cond, bar) do { unsigned _sp = 0; while (cond) { __builtin_amdgcn_s_sleep(1); \
    if ((++_sp & 255u) == 0u) { if (xb_ld(&(bar)[XB_TMO])) break; if (_sp > XB_SPIN_CAP) { atomicAdd(&(bar)[XB_TMO], 1u); break; } } } } while (0)

struct XcdBarrier {
    unsigned* bar; unsigned x;
    volatile LAS unsigned* st;
};

__device__ __forceinline__ XcdBarrier xcd_barrier_post(unsigned* bar, volatile LAS unsigned* st) {
    XcdBarrier b; b.bar = bar; b.x = xb_xcc_id(); b.st = st;
    if (threadIdx.x == 0) (void)xb_add(&bar[XB_XCNT(b.x)], 1u);
    return b;
}
__device__ __forceinline__ void xcd_barrier_complete(unsigned* bar, unsigned x, unsigned& nloc, unsigned& nx) {
    const unsigned G = gridDim.x * gridDim.y * gridDim.z;
    unsigned sum, cnt, mine, sp = 0u;
    for (;;) {
        sum = 0u; cnt = 0u; mine = 0u;
#pragma unroll
        for (unsigned j = 0; j < 16; ++j) { const unsigned c = xb_ld(&bar[XB_XCNT(j)]); sum += c; cnt += (c > 0u) ? 1u : 0u; mine = (j == x) ? c : mine; }
        if (sum == G) break;
        __builtin_amdgcn_s_sleep(1);
        if ((++sp & 255u) == 0u) { if (xb_ld(&bar[XB_TMO])) break; if (sp > XB_SPIN_CAP) { atomicAdd(&bar[XB_TMO], 1u); break; } }
    }
    nloc = mine > 0u ? mine : 1u; nx = cnt > 0u ? cnt : 1u;
}

__device__ __forceinline__ void xcd_barrier(const XcdBarrier& b) {
    asm volatile("s_waitcnt vmcnt(0)" ::: "memory");
    __syncthreads();
    if (threadIdx.x == 0) {
        unsigned* bar = b.bar;
        __builtin_amdgcn_s_waitcnt(0);
        unsigned nloc = b.st[0], nx = b.st[1];
        if (nloc == 0u) { xcd_barrier_complete(bar, b.x, nloc, nx); b.st[0] = nloc; b.st[1] = nx; }
        const unsigned old = xb_add(&bar[XB_XSUB(b.x)], 1u);
        const unsigned gen = old / nloc;
        if (old + 1u == (gen + 1u) * nloc) {
            __builtin_amdgcn_fence(__ATOMIC_RELEASE, "agent");
            asm volatile("s_waitcnt vmcnt(0)" ::: "memory");
            const unsigned og = xb_add(&bar[XB_TOP], 1u);
            const unsigned tg = og / nx;
            if (og + 1u == (tg + 1u) * nx) xb_add(&bar[XB_TOPGEN], 1u);
            else XB_SPIN(xb_ld(&bar[XB_TOPGEN]) == tg, bar);
            __builtin_amdgcn_fence(__ATOMIC_ACQUIRE, "agent");
            xb_add(&bar[XB_XGEN(b.x)], 1u);
            asm volatile("s_waitcnt vmcnt(0)" ::: "memory");
        } else {
            XB_SPIN(xb_ld(&bar[XB_XGEN(b.x)]) == gen, bar);
            __builtin_amdgcn_fence(__ATOMIC_ACQUIRE, "agent");
            asm volatile("s_waitcnt vmcnt(0)" ::: "memory");
        }
    }
    __syncthreads();
}

template <class Epi>
__device__ __forceinline__ void run_gemm(LAS unsigned char* lds, const bf16* A, const bf16* Bt, int N, int K, const Epi& E, const int tid) {
    pg8::Gemm g{A, Bt, T, N, K}; pg8::StaticOrder S; S.init(T, N, (int)gridDim.x, (int)blockIdx.x);
    pg8::gemm_phase<Epi, pg8::StaticOrder, true, true>(lds, g, S, E, tid);
}

__global__ void __launch_bounds__(512, 2) fwd_kernel(Params p) {
    extern __shared__ __attribute__((aligned(16))) unsigned char lds_raw[];
    LAS unsigned char* lds = (LAS unsigned char*)lds_raw;
    volatile LAS unsigned* bst = (volatile LAS unsigned*)(lds + NA_END + 64);
    if (threadIdx.x < 4) bst[threadIdx.x] = 0u;
    __syncthreads();
    XcdBarrier bar = xcd_barrier_post((unsigned*)(p.ws + WS_CTL) + CW_BAR, bst);
    for (int ph = p.ph_lo; ph < p.ph_hi; ++ph) {
        if (ph > p.ph_lo) { if (ph == p.ph_lo + 1) cg::this_grid().sync(); else xcd_barrier(bar); }
        int tid = threadIdx.x; asm volatile("" : "+v"(tid));
        if (ph == 0) {
            for (int e = blockIdx.x * 512 + tid; e < 12 * D; e += gridDim.x * 512) ((float*)(p.ws + WS_NG))[e] = p.norm_g[e];
            phase_mod(p, lds, tid); continue; }
        const int l = ph < 2 ? 0 : (ph - 2) / 8, s = ph < 2 ? 0 : (ph - 2) % 8 + 1;
        float* ssq_all = (float*)(p.ws + WS_SSQ);
        const float* shw_all = (const float*)(p.ws + WS_SHW);
        if (s == 0) {
            phase_shw(p, lds, tid); asm volatile("" : "+v"(tid)); phase_weights_a0(p, lds, tid); asm volatile("" : "+v"(tid)); phase_norm_first(p, tid);
        }
        else if (s == 4) phase_mixer(p, l, lds, tid);
        else if (s == 5) phase_combine(p, l, tid);
        else if (s == 1 || s == 7) {
            const int sub = s == 1 ? 0 : 2;
            pg8::EpiSwiGLU E{(bf16*)(p.ws + WS_BIG), ssq_all + (size_t)(l * 3 + sub) * T, shw_all + (size_t)(l * 3 + sub) * 24 * 5632};
            run_gemm(lds, (const bf16*)(p.ws + (s == 1 ? WS_H : WS_H2)), (const bf16*)(p.ws + (s == 1 ? WS_WGU0 : WS_WGU1)), 2 * FF, D, E, tid);
        } else if (s == 3) {
            pg8::EpiProj E{(bf16*)(p.ws + WS_BIG), ssq_all + (size_t)(l * 3 + 1) * T, shw_all + (size_t)(l * 3 + 1) * 24 * 5632};
            run_gemm(lds, (const bf16*)(p.ws + WS_H), (const bf16*)(p.ws + WS_WIN), NPJ, D, E, tid);
        } else {
            const int sub = s == 2 ? 0 : (s == 6 ? 1 : 2);
            pg8::EpiRes E{p.xp, p.xs, p.out, p.ws, l, sub, ((l == 0) && s == 2) ? 1 : 0};
            const bf16* A = (const bf16*)(p.ws + (s == 6 ? WS_H : WS_BIG));
            const bf16* Bt = (const bf16*)(p.ws + (s == 2 ? WS_WD0 : (s == 6 ? WS_WOUT : WS_WD1)));
            run_gemm(lds, A, Bt, D, s == 6 ? D : FF, E, tid);
        }
    }
}

#ifndef N_LAUNCH_MODE
#define N_LAUNCH_MODE 1
#endif

extern "C" void kernel_launch(void* const* d_in, const int* in_sizes, int n_in, void* d_out, int out_size, void* d_ws, size_t ws_size, hipStream_t stream) {
    static int grid = 0;
    if (grid == 0) {
        if (n_in != 18 || out_size != T * D || ws_size < WS_END) { fprintf(stderr, "kernel_launch: unexpected shapes (n_in %d out %d ws %zu)\n", n_in, out_size, ws_size); grid = -1; return; }
        int dev = 0, cus = 0, per_cu = 0;
        hipGetDevice(&dev);
        hipDeviceGetAttribute(&cus, hipDeviceAttributeMultiprocessorCount, dev);
        if (hipFuncSetAttribute((const void*)fwd_kernel, hipFuncAttributeMaxDynamicSharedMemorySize, LDS_BYTES) != hipSuccess) { fprintf(stderr, "kernel_launch: hipFuncSetAttribute failed\n"); grid = -1; return; }
        if (hipOccupancyMaxActiveBlocksPerMultiprocessor(&per_cu, (const void*)fwd_kernel, 512, LDS_BYTES) != hipSuccess || per_cu < 1) { fprintf(stderr, "kernel_launch: occupancy query says %d\n", per_cu); per_cu = 1; }
        (void)hipGetLastError();
        grid = cus;
    }
    if (grid < 0) return;
    hipMemsetAsync((char*)d_ws + WS_CTL, 0, CTL_BYTES, stream);
    Params p{};
    p.xp = (const float*)d_in[0]; p.xs = (const float*)d_in[1]; p.cp = (const float*)d_in[2]; p.cs = (const float*)d_in[3];
    p.w_mod = (const float*)d_in[4]; p.b_mod = (const float*)d_in[5]; p.norm_g = (const float*)d_in[6];
    p.wg = (const float*)d_in[7]; p.wu = (const float*)d_in[8]; p.wd = (const float*)d_in[9];
    p.w_in = (const float*)d_in[10]; p.w_out = (const float*)d_in[11]; p.lbf = (const float*)d_in[12]; p.lbb = (const float*)d_in[13];
    p.hgn = (const float*)d_in[14]; p.qng = (const float*)d_in[15]; p.kng = (const float*)d_in[16]; p.rpb = (const float*)d_in[17];
    p.out = (float*)d_out; p.ws = (unsigned char*)d_ws;
#if N_LAUNCH_MODE == 1
    p.ph_lo = 0; p.ph_hi = NPHASE;
    void* args[] = {&p};
    hipError_t e = hipLaunchCooperativeKernel((const void*)fwd_kernel, dim3(grid), dim3(512), args, LDS_BYTES, stream);
    if (e != hipSuccess) fprintf(stderr, "cooperative launch failed: %s (grid %d)\n", hipGetErrorString(e), grid);
#else
    for (int ph = 0; ph < NPHASE; ++ph) {
        p.ph_lo = ph; p.ph_hi = ph + 1;
        hipLaunchKernelGGL(fwd_kernel, dim3(grid), dim3(512), LDS_BYTES, stream, p);
    }
#endif
}
```

```cpp
#include <hip/hip_runtime.h>
#include <hip/hip_cooperative_groups.h>
#include <cstdio>
#include <cstdint>
namespace cg = cooperative_groups;
namespace pg8 {
#define PG8_LAS __attribute__((address_space(3)))
typedef unsigned short bf16_t;
typedef short bf16x8 __attribute__((ext_vector_type(8)));
typedef float f32x4 __attribute__((ext_vector_type(4)));
typedef unsigned u32x4 __attribute__((ext_vector_type(4)));
constexpr int BM = 256, BK = 64, HALF = 128, HTB = HALF * BK * 2  , STAGE_BYTES = 8 * HTB, NXCD = 8, WGM = 8;

__host__ __device__ __forceinline__ int lds_byte(int r, int c) { const int st = (r >> 4) * 2 + (c >> 5), rr = r & 15, cc = c & 31, ob = rr * 64 + cc * 2; return st * 1024 + (ob ^ (((ob >> 9) & 1) << 5)); }
__host__ __device__ __forceinline__ void stage_rc(int b, int& R, int& C) { const int st = b / 1024, sb = b % 1024, swz = sb ^ (((sb >> 9) & 1) << 5); R = (st >> 1) * 16 + swz / 64; C = (st & 1) * 32 + (swz % 64) / 2; }
__host__ __device__ __forceinline__ int perm32(int rho) { const int n = rho >> 4, i = rho & 15; return 8 * (i >> 2) + 4 * n + (i & 3); }

struct Unit { int pm, pn; };
struct Gemm { const bf16_t* A; const bf16_t* Bt; int M, N, K; };

struct StaticOrder {
    int nM, nN, nwg, G, c;
    __host__ __device__ void init(int M, int N, int G_, int c_) { nM = M / BM; nN = N / BM; nwg = nM * nN; G = G_; c = c_; }
    __host__ __device__ bool next(int i, Unit& u) const {
        const long L = (long)i * G + c; if (L >= nwg) return false;
        int wgid = (int)L; { const int q = nwg / NXCD, r = nwg % NXCD, xcd = wgid % NXCD, off = wgid / NXCD; wgid = (xcd < r ? xcd * (q + 1) : r * (q + 1) + (xcd - r) * q) + off; }
        const int nig = WGM * nN, gid = wgid / nig, fm = gid * WGM, gsz = (nM - fm) < WGM ? (nM - fm) : WGM;
        u.pm = fm + ((wgid % nig) % gsz); u.pn = (wgid % nig) / gsz; return true;
    }
    __device__ __forceinline__ void a_ready(const Unit&) const {}
    __device__ __forceinline__ void done(const Unit&) const {}
};

__device__ __forceinline__ unsigned cvt_pk_bf16(float lo, float hi) { unsigned r; asm volatile("v_cvt_pk_bf16_f32 %0, %1, %2" : "=v"(r) : "v"(lo), "v"(hi)); return r; }
typedef float f32x2 __attribute__((ext_vector_type(2)));
__device__ __forceinline__ f32x2 gelu_pk(f32x2 v) {
    const f32x2 av = __builtin_elementwise_abs(v), d = av * 0.2316418882f + 1.0f;
    f32x2 t; t.x = __builtin_amdgcn_rcpf(d.x); t.y = __builtin_amdgcn_rcpf(d.y);
    f32x2 q = t * 0.5307027145f + (-0.7265760135f); q = q * t + 0.7107068705f; q = q * t + (-0.142248368f); q = q * t + 0.127414796f; q = q * t;
    const f32x2 s = (v * v) * (-0.72134752044f);
    f32x2 e; e.x = __builtin_amdgcn_exp2f(s.x); e.y = __builtin_amdgcn_exp2f(s.y);
    const f32x2 m = v * (q * e), r = v - m;
    f32x2 o; o.x = v.x < 0.f ? m.x : r.x; o.y = v.y < 0.f ? m.y : r.y; return o;
}

template <int ACT  > struct EpiBf16 {
    static constexpr bool PERM = true, AFTER_DRAIN = false; static_assert(ACT == 0 || ACT == 1, "EpiBf16: ACT is 0 (none) or 1 (gelu_pk)");
    bf16_t* O; int ldc; const float* bias; int split_cols; size_t split_stride; float scale0;
    __device__ __forceinline__ void operator()(const f32x4 (&acc)[2][2][4][2], const Unit& u, int wr, int wc, int fr, int fq) const {
        const int row0 = u.pm * BM + wr * 64 + fr; int colt = u.pn * BM; bf16_t* base = O;
        float sc = 1.f; if (split_cols) { const int t = colt / split_cols; base += (size_t)t * split_stride; colt -= t * split_cols; if (t == 0) sc = scale0; }
        const int col0 = colt + wc * 32 + 8 * fq, bcol0 = u.pn * BM + wc * 32 + 8 * fq;
        f32x4 bv[2][2];
#pragma unroll
        for (int bj = 0; bj < 2; ++bj)
#pragma unroll
            for (int n = 0; n < 2; ++n) bv[bj][n] = bias ? *(const f32x4*)(bias + bcol0 + bj * HALF + 4 * n) : (f32x4){0.f, 0.f, 0.f, 0.f};
#pragma unroll
        for (int ai = 0; ai < 2; ++ai)
#pragma unroll
            for (int m = 0; m < 4; ++m) { bf16_t* rowp = base + (size_t)(row0 + ai * HALF + m * 16) * ldc + col0;
#pragma unroll
                for (int bj = 0; bj < 2; ++bj) { f32x4 v0 = acc[ai][bj][m][0] + bv[bj][0], v1 = acc[ai][bj][m][1] + bv[bj][1];
                    if (ACT == 1) { f32x2 a = gelu_pk((f32x2){v0[0], v0[1]}), b = gelu_pk((f32x2){v0[2], v0[3]}), c = gelu_pk((f32x2){v1[0], v1[1]}), d = gelu_pk((f32x2){v1[2], v1[3]});
                        v0 = (f32x4){a.x, a.y, b.x, b.y}; v1 = (f32x4){c.x, c.y, d.x, d.y}; }
                    v0 = v0 * sc; v1 = v1 * sc; u32x4 w; w.x = cvt_pk_bf16(v0[0], v0[1]); w.y = cvt_pk_bf16(v0[2], v0[3]); w.z = cvt_pk_bf16(v1[0], v1[1]); w.w = cvt_pk_bf16(v1[2], v1[3]);
                    *(u32x4*)(rowp + bj * HALF) = w; } }
    }
};
template <class Epi, class Sched, bool ALIGN_EPI = false, bool SP2 = false>
__device__ __forceinline__ void gemm_phase(PG8_LAS unsigned char* lds, const Gemm g, const Sched& S, const Epi& E, const int tid_in) {
    const int tid = tid_in, wid = __builtin_amdgcn_readfirstlane(tid >> 6), lane = tid & 63, wr = wid >> 2, wc = wid & 3, fr = lane & 15, fq = lane >> 4;
    const int K = g.K, nt = K / BK;
    unsigned voffA[2], voffB[2];
#pragma unroll
    for (int i = 0; i < 2; ++i) { int R, C; stage_rc(tid * 16 + i * 8192, R, C); const int Rb = Epi::PERM ? ((R & ~31) + perm32(R & 31)) : R;
        voffA[i] = (unsigned)(R * K + C) * 2u; voffB[i] = (unsigned)(Rb * K + C) * 2u; }
    const size_t kstep = (size_t)(BK * 2);
    const size_t hstep = (size_t)HALF * K * 2;
    const size_t tstep = 2 * hstep;
    const unsigned ldsw = (unsigned)wid * 1024u;
    const int aoff = lds_byte(wr * 64 + fr, fq * 8), boff = lds_byte(wc * 32 + fr, fq * 8);
#define PG8_SA(b, h) (((b) * 2 + (h)) * HTB)
#define PG8_SB(b, h) ((4 + (b) * 2 + (h)) * HTB)
#define PG8_STAGE(bufoff, gbase, voff) do { _Pragma("unroll") for (int _i = 0; _i < 2; ++_i) \
        __builtin_amdgcn_global_load_lds((const unsigned*)((const char*)(gbase) + (voff)[_i]), (PG8_LAS unsigned*)(lds + (bufoff) + ldsw + _i * 8192), 16, 0, 0); } while (0)
#define PG8_LDA(dst, b, h) do { _Pragma("unroll") for (int m = 0; m < 4; ++m) _Pragma("unroll") for (int k = 0; k < 2; ++k) dst[m][k] = *(const PG8_LAS bf16x8*)(lds + PG8_SA(b, h) + aoff + m * 2048 + k * 1024); } while (0)
#define PG8_LDB(dst, b, h) do { _Pragma("unroll") for (int n = 0; n < 2; ++n) _Pragma("unroll") for (int k = 0; k < 2; ++k) dst[n][k] = *(const PG8_LAS bf16x8*)(lds + PG8_SB(b, h) + boff + n * 2048 + k * 1024); } while (0)
#define PG8_MMA(ai, bj, At, Bt) do { __builtin_amdgcn_s_setprio(1); _Pragma("unroll") for (int m = 0; m < 4; ++m) _Pragma("unroll") for (int n = 0; n < 2; ++n) _Pragma("unroll") for (int k = 0; k < 2; ++k) \
        acc[ai][bj][m][n] = __builtin_amdgcn_mfma_f32_16x16x32_bf16(Bt[n][k], At[m][k], acc[ai][bj][m][n], 0, 0, 0); __builtin_amdgcn_s_setprio(0); } while (0)
#define PG8_WAIT_V(n) asm volatile("s_waitcnt vmcnt(" #n ")" ::: "memory")
#define PG8_WAIT_L(n) asm volatile("s_waitcnt lgkmcnt(" #n ")" ::: "memory")
#define PG8_BAR __builtin_amdgcn_s_barrier()
#define PG8_SCHED __builtin_amdgcn_sched_barrier(0)
    Unit cur, nxt; int ui = 0;
    if (!S.next(0, cur)) return;
    f32x4 acc[2][2][4][2];
#pragma unroll
    for (int a = 0; a < 2; ++a)
#pragma unroll
        for (int b = 0; b < 2; ++b)
#pragma unroll
            for (int m = 0; m < 4; ++m)
#pragma unroll
                for (int n = 0; n < 2; ++n) acc[a][b][m][n] = (f32x4){0.f, 0.f, 0.f, 0.f};
    bf16x8 At[4][2], B0[2][2], B1[2][2];
    const char* cA = (const char*)g.A + (size_t)cur.pm * tstep; const char* cB = (const char*)g.Bt + (size_t)cur.pn * tstep;
    S.a_ready(cur);
    if constexpr (SP2) {
        PG8_STAGE(PG8_SB(0, 0), cB, voffB); PG8_STAGE(PG8_SB(0, 1), cB + hstep, voffB); PG8_STAGE(PG8_SA(0, 0), cA, voffA); PG8_STAGE(PG8_SA(0, 1), cA + hstep, voffA);
        if (wr == 1) PG8_BAR;
        PG8_WAIT_V(2); PG8_BAR;
        PG8_STAGE(PG8_SB(1, 0), cB + kstep, voffB); PG8_STAGE(PG8_SA(1, 0), cA + kstep, voffA); PG8_STAGE(PG8_SB(1, 1), cB + hstep + kstep, voffB);
        PG8_WAIT_V(6); PG8_BAR;
    } else {
        PG8_STAGE(PG8_SB(0, 0), cB, voffB); PG8_STAGE(PG8_SA(0, 0), cA, voffA); PG8_STAGE(PG8_SB(0, 1), cB + hstep, voffB); PG8_STAGE(PG8_SA(0, 1), cA + hstep, voffA);
        if (wr == 1) PG8_BAR;
        PG8_WAIT_V(4); PG8_BAR;
        PG8_STAGE(PG8_SB(1, 0), cB + kstep, voffB); PG8_STAGE(PG8_SA(1, 0), cA + kstep, voffA); PG8_STAGE(PG8_SB(1, 1), cB + hstep + kstep, voffB);
        PG8_WAIT_V(6); PG8_BAR;
    }
    for (;;) {
        const bool has_next = S.next(ui + 1, nxt);
        const char* nA = has_next ? (const char*)g.A + (size_t)nxt.pm * tstep : cA; const char* nB = has_next ? (const char*)g.Bt + (size_t)nxt.pn * tstep : cB;
        for (int t = 0; t < nt; t += 2) {
            const bool last = (t == nt - 2);
            const char* a1 = cA + (size_t)(t + 1) * kstep;
            const char* a2 = last ? nA : cA + (size_t)(t + 2) * kstep; const char* b2 = last ? nB : cB + (size_t)(t + 2) * kstep;
            const char* a3 = a2 + kstep; const char* b3 = b2 + kstep;
            if (last && has_next) S.a_ready(nxt);
            if constexpr (SP2) {
            PG8_LDB(B0, 0, 0); PG8_LDB(B1, 0, 1); PG8_SCHED; PG8_LDA(At, 0, 0); PG8_STAGE(PG8_SA(1, 1), a1 + hstep, voffA);
            PG8_WAIT_V(8); PG8_WAIT_L(0); PG8_BAR; PG8_MMA(0, 0, At, B0); PG8_MMA(0, 1, At, B1); PG8_BAR; PG8_SCHED;
            PG8_LDA(At, 0, 1); PG8_STAGE(PG8_SB(0, 0), b2, voffB); PG8_STAGE(PG8_SB(0, 1), b2 + hstep, voffB); PG8_STAGE(PG8_SA(0, 0), a2, voffA);
            PG8_WAIT_V(8); PG8_WAIT_L(0); PG8_BAR; PG8_MMA(1, 0, At, B0); PG8_MMA(1, 1, At, B1); PG8_BAR; PG8_SCHED;
            PG8_LDB(B0, 1, 0); PG8_LDB(B1, 1, 1); PG8_SCHED; PG8_LDA(At, 1, 0); PG8_STAGE(PG8_SA(0, 1), a2 + hstep, voffA);
            PG8_WAIT_V(8); PG8_WAIT_L(0); PG8_BAR; PG8_MMA(0, 0, At, B0); PG8_MMA(0, 1, At, B1); PG8_BAR; PG8_SCHED;
            PG8_LDA(At, 1, 1); PG8_STAGE(PG8_SB(1, 0), b3, voffB); PG8_STAGE(PG8_SB(1, 1), b3 + hstep, voffB); PG8_STAGE(PG8_SA(1, 0), a3, voffA);
            PG8_WAIT_V(8); PG8_WAIT_L(0); PG8_BAR; PG8_MMA(1, 0, At, B0); PG8_MMA(1, 1, At, B1); PG8_BAR; PG8_SCHED;
            } else {
            PG8_LDB(B0, 0, 0); PG8_SCHED; PG8_LDA(At, 0, 0); PG8_STAGE(PG8_SA(1, 1), a1 + hstep, voffA);
            PG8_WAIT_L(8); PG8_BAR; PG8_WAIT_L(0); PG8_MMA(0, 0, At, B0); PG8_BAR; PG8_SCHED;
            PG8_LDB(B1, 0, 1); PG8_STAGE(PG8_SB(0, 0), b2, voffB);
            PG8_BAR; PG8_WAIT_L(0); PG8_MMA(0, 1, At, B1); PG8_BAR;
            PG8_LDA(At, 0, 1); PG8_STAGE(PG8_SA(0, 0), a2, voffA);
            PG8_BAR; PG8_WAIT_L(0); PG8_MMA(1, 0, At, B0); PG8_BAR; PG8_SCHED;
            PG8_STAGE(PG8_SB(0, 1), b2 + hstep, voffB);
            PG8_WAIT_V(6); PG8_BAR; PG8_MMA(1, 1, At, B1); PG8_BAR;
            PG8_LDB(B0, 1, 0); PG8_SCHED; PG8_LDA(At, 1, 0); PG8_STAGE(PG8_SA(0, 1), a2 + hstep, voffA);
            PG8_WAIT_L(8); PG8_BAR; PG8_WAIT_L(0); PG8_MMA(0, 0, At, B0); PG8_BAR; PG8_SCHED;
            PG8_LDB(B1, 1, 1); PG8_STAGE(PG8_SB(1, 0), b3, voffB);
            PG8_BAR; PG8_WAIT_L(0); PG8_MMA(0, 1, At, B1); PG8_BAR;
            PG8_LDA(At, 1, 1); PG8_STAGE(PG8_SA(1, 0), a3, voffA);
            PG8_BAR; PG8_WAIT_L(0); PG8_MMA(1, 0, At, B0); PG8_BAR; PG8_SCHED;
            PG8_STAGE(PG8_SB(1, 1), b3 + hstep, voffB);
            PG8_WAIT_V(6); PG8_BAR; PG8_MMA(1, 1, At, B1); PG8_BAR;
            }
        }
        if constexpr (ALIGN_EPI) { if (wr == 0) PG8_BAR; }
        if constexpr (!Epi::AFTER_DRAIN) { E(acc, cur, wr, wc, fr, fq); S.done(cur); }
        if (!has_next) break;
#pragma unroll
        for (int a = 0; a < 2; ++a)
#pragma unroll
            for (int b = 0; b < 2; ++b)
#pragma unroll
                for (int m = 0; m < 4; ++m)
#pragma unroll
                    for (int n = 0; n < 2; ++n) acc[a][b][m][n] = (f32x4){0.f, 0.f, 0.f, 0.f};
        cur = nxt; cA = nA; cB = nB; ++ui;
        if constexpr (ALIGN_EPI) { if (wr == 1) PG8_BAR; }
    }
    PG8_WAIT_V(0);
    if constexpr (!ALIGN_EPI) { if (wr == 0) PG8_BAR; }
    PG8_BAR;
    if constexpr (Epi::AFTER_DRAIN) { E.fused(acc, cur, wr, wc, fr, fq, lds, wid, lane); S.done(cur); }
#undef PG8_SA
#undef PG8_SB
#undef PG8_STAGE
#undef PG8_LDA
#undef PG8_LDB
#undef PG8_MMA
#undef PG8_WAIT_V
#undef PG8_WAIT_L
#undef PG8_BAR
#undef PG8_SCHED
}
}

namespace pg8 {
__device__ __forceinline__ float silu_f(float g) { return g * __builtin_amdgcn_rcpf(1.0f + __expf(-g)); }
__device__ __forceinline__ float sigm_f(float g) { return __builtin_amdgcn_rcpf(1.0f + __expf(-g)); }
struct EpiSwiGLU {
    static constexpr bool PERM = true, AFTER_DRAIN = false;
    bf16_t* O; const float* ssq; const float* shw;
    __device__ __forceinline__ void operator()(const f32x4 (&acc)[2][2][4][2], const Unit& u, int wr, int wc, int fr, int fq) const {
        const int r00 = u.pm * BM;
        const int b = r00 < 32768 ? (r00 >> 11) : 16 + ((r00 - 32768) >> 12);
        const int row0 = r00 + wr * 64 + fr; const int col0 = u.pn * 128 + wc * 32 + 8 * fq;
        const float* sp = shw + (size_t)b * 5632 + u.pn * BM + wc * 32 + 8 * fq;
        const f32x4 sg0 = *(const f32x4*)(sp), sg1 = *(const f32x4*)(sp + 4), su0 = *(const f32x4*)(sp + HALF), su1 = *(const f32x4*)(sp + HALF + 4);
#pragma unroll
        for (int ai = 0; ai < 2; ++ai)
#pragma unroll
            for (int m = 0; m < 4; ++m) {
                const int row = row0 + ai * HALF + m * 16;
                const float rs = __builtin_amdgcn_rsqf(ssq[row] * (1.0f / 1024.0f) + 1e-6f);
                bf16_t* rowp = O + (size_t)row * 2816 + col0;
                const f32x4 g0 = acc[ai][0][m][0] * rs + sg0, g1 = acc[ai][0][m][1] * rs + sg1, u0 = acc[ai][1][m][0] * rs + su0, u1 = acc[ai][1][m][1] * rs + su1;
                u32x4 w;
                w.x = cvt_pk_bf16(silu_f(g0[0]) * u0[0], silu_f(g0[1]) * u0[1]);
                w.y = cvt_pk_bf16(silu_f(g0[2]) * u0[2], silu_f(g0[3]) * u0[3]);
                w.z = cvt_pk_bf16(silu_f(g1[0]) * u1[0], silu_f(g1[1]) * u1[1]);
                w.w = cvt_pk_bf16(silu_f(g1[2]) * u1[2], silu_f(g1[3]) * u1[3]);
                *(u32x4*)rowp = w;
            }
    }
};
struct EpiProj {
    static constexpr bool PERM = true, AFTER_DRAIN = false;
    bf16_t* O; const float* ssq; const float* shw;
    __device__ __forceinline__ void operator()(const f32x4 (&acc)[2][2][4][2], const Unit& u, int wr, int wc, int fr, int fq) const {
        const int r00 = u.pm * BM;
        const int b = r00 < 32768 ? (r00 >> 11) : 16 + ((r00 - 32768) >> 12);
        const int row0 = r00 + wr * 64 + fr; const int col0 = u.pn * BM + wc * 32 + 8 * fq;
        const int mode = (u.pn < 2 || u.pn == 8 || u.pn == 9) ? 1 : ((u.pn >= 2 && u.pn < 6) ? 2 : 0);
        const float* sp = shw + (size_t)b * 5632 + col0;
        f32x4 sv[2][2];
#pragma unroll
        for (int bj = 0; bj < 2; ++bj) { sv[bj][0] = *(const f32x4*)(sp + bj * HALF); sv[bj][1] = *(const f32x4*)(sp + bj * HALF + 4); }
#pragma unroll
        for (int ai = 0; ai < 2; ++ai)
#pragma unroll
            for (int m = 0; m < 4; ++m) { const int row = row0 + ai * HALF + m * 16;
                const float rs = __builtin_amdgcn_rsqf(ssq[row] * (1.0f / 1024.0f) + 1e-6f);
                bf16_t* rowp = O + (size_t)row * 4224 + col0;
#pragma unroll
                for (int bj = 0; bj < 2; ++bj) { f32x4 v0 = acc[ai][bj][m][0] * rs + sv[bj][0], v1 = acc[ai][bj][m][1] * rs + sv[bj][1];
                    if (mode == 1) {
#pragma unroll
                        for (int e = 0; e < 4; ++e) { v0[e] = silu_f(v0[e]); v1[e] = silu_f(v1[e]); }
                    } else if (mode == 2) {
#pragma unroll
                        for (int e = 0; e < 4; ++e) { v0[e] = sigm_f(v0[e]); v1[e] = sigm_f(v1[e]); }
                    }
                    u32x4 w; w.x = cvt_pk_bf16(v0[0], v0[1]); w.y = cvt_pk_bf16(v0[2], v0[3]); w.z = cvt_pk_bf16(v1[0], v1[1]); w.w = cvt_pk_bf16(v1[2], v1[3]);
                    *(u32x4*)(rowp + bj * HALF) = w; } }
    }
};
struct EpiRes {
    static constexpr bool PERM = true, AFTER_DRAIN = false;
    const float* xp; const float* xs; float* out; unsigned char* ws;
    int l, sub, fx;
    __device__ __forceinline__ void operator()(const f32x4 (&acc)[2][2][4][2], const Unit& u, int wr, int wc, int fr, int fq) const {
        constexpr size_t kMiB = 1u << 20;
        const int r00 = u.pm * BM;
        const int b = r00 < 32768 ? (r00 >> 11) : 16 + ((r00 - 32768) >> 12);
        const float* mod = (const float*)(ws + 4 * kMiB);
        const float* gp = mod + ((size_t)(l * 24 + b) * 9 + sub * 3 + 2) * 1024;
        const float coef = sub == 1 ? 1.0f : 0.5f;
        const int nl = sub == 2 ? l + 1 : l, nsub = sub == 2 ? 0 : sub + 1;
        const bool has_next = nl < 4;
        const int nidx = has_next ? nl * 3 + nsub : 0;
        bf16_t* Hn = (bf16_t*)(ws + (sub == 1 ? 576 : 64) * kMiB);
        float* ssqn = (float*)(ws + 1 * kMiB) + (size_t)nidx * 65536;
        const float* ng = (const float*)(ws + 7 * kMiB + 768 * 1024) + (size_t)nidx * 1024;
        const float* nsc = mod + ((size_t)((has_next ? nl : 0) * 24 + b) * 9 + nsub * 3 + 1) * 1024;
        const int col0 = u.pn * BM + wc * 32 + 8 * fq;
        f32x4 gv[2][2], hm[2][2];
#pragma unroll
        for (int bj = 0; bj < 2; ++bj)
#pragma unroll
            for (int n = 0; n < 2; ++n) {
                gv[bj][n] = *(const f32x4*)(gp + col0 + bj * HALF + n * 4) * coef;
                hm[bj][n] = *(const f32x4*)(ng + col0 + bj * HALF + n * 4) * (*(const f32x4*)(nsc + col0 + bj * HALF + n * 4) + 1.0f);
            }
        const float* base = fx ? ((r00 < 32768) ? xp : xs - (size_t)32768 * 1024) : out;
#pragma unroll
        for (int ai = 0; ai < 2; ++ai)
#pragma unroll
            for (int m = 0; m < 4; ++m) {
                const int row = r00 + ai * HALF + wr * 64 + m * 16 + fr;
                const size_t off = (size_t)row * 1024 + col0;
                float sq = 0.f;
#pragma unroll
                for (int bj = 0; bj < 2; ++bj) {
                    const f32x4 x0 = *(const f32x4*)(base + off + bj * HALF), x1 = *(const f32x4*)(base + off + bj * HALF + 4);
                    const f32x4 o0 = x0 + gv[bj][0] * acc[ai][bj][m][0], o1 = x1 + gv[bj][1] * acc[ai][bj][m][1];
                    *(f32x4*)(out + off + bj * HALF) = o0; *(f32x4*)(out + off + bj * HALF + 4) = o1;
                    if (has_next) {
                        sq += ((o0[0] * o0[0] + o0[1] * o0[1]) + (o0[2] * o0[2] + o0[3] * o0[3])) + ((o1[0] * o1[0] + o1[1] * o1[1]) + (o1[2] * o1[2] + o1[3] * o1[3]));
                        const f32x4 h0 = o0 * hm[bj][0], h1 = o1 * hm[bj][1];
                        u32x4 w; w.x = cvt_pk_bf16(h0[0], h0[1]); w.y = cvt_pk_bf16(h0[2], h0[3]); w.z = cvt_pk_bf16(h1[0], h1[1]); w.w = cvt_pk_bf16(h1[2], h1[3]);
                        *(u32x4*)(Hn + off + bj * HALF) = w;
                    }
                }
                if (has_next) {
                    sq += __shfl_xor(sq, 16); sq += __shfl_xor(sq, 32);
                    if (fq == 0) unsafeAtomicAdd(ssqn + row, sq);
                }
            }
    }
};
}

#define LAS __attribute__((address_space(3)))
typedef unsigned short bf16;
typedef unsigned u32x4 __attribute__((ext_vector_type(4)));
typedef unsigned u32x2 __attribute__((ext_vector_type(2)));
typedef float f32x4 __attribute__((ext_vector_type(4)));
constexpr int D = 1024, T = 65536, TP = 32768, FF = 2816, NPJ = 4096, DEPTH = 4, NB = 24;
constexpr int PJP = 4096 + 128;
constexpr float EPS = 1e-6f;
constexpr size_t MiB = 1u << 20;
constexpr size_t WS_CTL = 0, CTL_BYTES = 4 * MiB;
constexpr size_t WS_SSQ = 1 * MiB;
constexpr size_t WS_MOD = 4 * MiB;
constexpr size_t WS_NG = 7 * MiB + 768 * 1024;
constexpr size_t WS_SHW = 8 * MiB;
constexpr size_t WS_WGU0 = 16 * MiB, WS_WGU1 = 27 * MiB, WS_WD0 = 38 * MiB, WS_WD1 = 44 * MiB, WS_WIN = 50 * MiB, WS_WOUT = 58 * MiB;
constexpr size_t WS_H = 64 * MiB;
constexpr size_t WS_BIG = 192 * MiB;
constexpr size_t WS_H2 = 576 * MiB;
constexpr size_t WS_END = 720 * MiB;
constexpr int LDS_BYTES = 158720;
constexpr int NPHASE = 2 + 8 * DEPTH;

struct Params {
    const float *xp, *xs, *cp, *cs, *w_mod, *b_mod, *norm_g, *wg, *wu, *wd, *w_in, *w_out, *lbf, *lbb, *hgn, *qng, *kng, *rpb;
    float* out; unsigned char* ws;
    int ph_lo, ph_hi;
};

__device__ __forceinline__ unsigned f2bf(float f) { unsigned u = __builtin_bit_cast(unsigned, f); return (u + 0x7fffu + ((u >> 16) & 1u)) >> 16; }
typedef float f32x2_t __attribute__((ext_vector_type(2)));
typedef __bf16 bf16x2_t __attribute__((ext_vector_type(2)));
typedef short bf16x8 __attribute__((ext_vector_type(8)));
__device__ __forceinline__ unsigned pk2(float lo, float hi) { f32x2_t v = {lo, hi}; bf16x2_t r = __builtin_convertvector(v, bf16x2_t); return __builtin_bit_cast(unsigned, r); }
#define LBAR() do { asm volatile("s_waitcnt lgkmcnt(0)" ::: "memory"); __builtin_amdgcn_s_barrier(); asm volatile("" ::: "memory"); } while (0)
#define MFMA16(a, b, c) __builtin_amdgcn_mfma_f32_16x16x32_bf16((a), (b), (c), 0, 0, 0)
__device__ __forceinline__ float bflo(unsigned w) { return __uint_as_float(w << 16); }
__device__ __forceinline__ float bfhi(unsigned w) { return __uint_as_float(w & 0xffff0000u); }
__device__ __forceinline__ void unpack8(const u32x4 w, float (&f)[8]) {
    f[0] = bflo(w.x); f[1] = bfhi(w.x); f[2] = bflo(w.y); f[3] = bfhi(w.y); f[4] = bflo(w.z); f[5] = bfhi(w.z); f[6] = bflo(w.w); f[7] = bfhi(w.w);
}
__device__ __forceinline__ float wave_sum(float v) {
#pragma unroll
    for (int o = 1; o < 64; o <<= 1) v += __shfl_xor(v, o);
    return v;
}
__device__ __forceinline__ int batch_of_row(int row) { return row < TP ? (row >> 11) : 16 + ((row - TP) >> 12); }
__device__ __forceinline__ float silu(float g) { return g / (1.0f + __expf(-g)); }
__device__ __forceinline__ float sigm(float g) { return 1.0f / (1.0f + __expf(-g)); }

__device__ __forceinline__ void gemv24_item(const float* W, int N, int j0, LAS float* sc, LAS float* red, float (&res)[6], const int tid) {
    const int lane = tid & 63, wave = tid >> 6, cg = lane & 31, ks = wave * 2 + (lane >> 5);
    f32x4 acc[24];
#pragma unroll
    for (int b = 0; b < 24; ++b) acc[b] = (f32x4){0.f, 0.f, 0.f, 0.f};
    const float* w = W + (size_t)(ks * 64) * N + j0 + cg * 4;
#pragma unroll 8
    for (int kk = 0; kk < 64; ++kk) {
        const f32x4 wv = *(const f32x4*)(w + (size_t)kk * N);
        const LAS f32x4* s4 = (const LAS f32x4*)(sc + (ks * 64 + kk) * 24);
#pragma unroll
        for (int b4 = 0; b4 < 6; ++b4) { const f32x4 s = s4[b4]; acc[4 * b4] += wv * s[0]; acc[4 * b4 + 1] += wv * s[1]; acc[4 * b4 + 2] += wv * s[2]; acc[4 * b4 + 3] += wv * s[3]; }
    }
#pragma unroll
    for (int bg = 0; bg < 3; ++bg) {
#pragma unroll
        for (int bb = 0; bb < 8; ++bb) {
            f32x4 a = acc[8 * bg + bb];
            a[0] += __shfl_xor(a[0], 32); a[1] += __shfl_xor(a[1], 32); a[2] += __shfl_xor(a[2], 32); a[3] += __shfl_xor(a[3], 32);
            if (lane < 32) *(LAS f32x4*)(red + ((wave * 8 + bb) * 128 + cg * 4)) = a;
        }
        __syncthreads();
#pragma unroll
        for (int h = 0; h < 2; ++h) {
            const int bb = 4 * h + (tid >> 7), j = tid & 127;
            float s = 0.f;
#pragma unroll
            for (int wv = 0; wv < 8; ++wv) s += red[(wv * 8 + bb) * 128 + j];
            res[2 * bg + h] = s;
        }
        __syncthreads();
    }
}
__device__ __forceinline__ void phase_mod(const Params& p, LAS unsigned char* lds, const int tid) {
    LAS float* sc = (LAS float*)lds;
    LAS float* red = (LAS float*)(lds + 98304);
    float* mod = (float*)(p.ws + WS_MOD);
    for (int e = tid; e < 24 * 1024; e += 512) {
        const int b = e >> 10, k = e & 1023;
        const float c = b < 16 ? p.cp[b * 1024 + k] : p.cs[(b - 16) * 1024 + k];
        sc[k * 24 + b] = silu(c);
    }
    __syncthreads();
    for (int item = blockIdx.x; item < 288; item += gridDim.x) {
        const int l = item / 72, j0 = (item % 72) * 128;
        float res[6];
        gemv24_item(p.w_mod + (size_t)l * 1024 * 9216, 9216, j0, sc, red, res, tid);
#pragma unroll
        for (int i = 0; i < 6; ++i) { const int e = tid + 512 * i, b = e >> 7, j = e & 127; mod[((size_t)l * 24 + b) * 9216 + j0 + j] = res[i] + p.b_mod[l * 9216 + j0 + j]; }
    }
    __syncthreads();
}

__device__ __forceinline__ void phase_shw(const Params& p, LAS unsigned char* lds, const int tid) {
    LAS float* sc = (LAS float*)lds;
    LAS float* red = (LAS float*)(lds + 98304);
    const float* mod = (const float*)(p.ws + WS_MOD);
    float* shw = (float*)(p.ws + WS_SHW);
    int have = -1;
    for (int it = 0; it < 2 * ((480 + 2 * (int)gridDim.x - 1) / (2 * (int)gridDim.x)); ++it) {
        const int item = ((it >> 1) * (int)gridDim.x + (int)blockIdx.x) * 2 + (it & 1);
        if (item >= 480) continue;
        const int l = item / 120, r = item % 120;
        const int sub = r < 44 ? 0 : (r < 76 ? 1 : 2);
        const int mat = sub == 1 ? 2 : ((r < 22 || (r >= 76 && r < 98)) ? 0 : 1);
        const int blk = r < 22 ? r : (r < 44 ? r - 22 : (r < 76 ? r - 44 : (r < 98 ? r - 76 : r - 98)));
        const int ffn = sub == 2 ? 1 : 0;
        const int N = mat == 2 ? NPJ : FF;
        const size_t woff = mat == 2 ? (size_t)l * D * NPJ : (size_t)(l * 2 + ffn) * D * FF;
        const float* W = (mat == 2 ? p.w_in : (mat == 0 ? p.wg : p.wu)) + woff;
        const int j0 = blk * 128;
        const int d0 = mat == 2 ? j0 : (blk * 256 + (mat == 1 ? 128 : 0));
        if (have != l * 3 + sub) {
            __syncthreads();
            for (int e = tid; e < 24 * 1024; e += 512) {
                const int b = e >> 10, k = e & 1023;
                sc[k * 24 + b] = mod[((size_t)(l * 24 + b) * 9 + sub * 3) * D + k];
            }
            have = l * 3 + sub;
            __syncthreads();
        }
        float res[6];
        gemv24_item(W, N, j0, sc, red, res, tid);
#pragma unroll
        for (int i = 0; i < 6; ++i) { const int e = tid + 512 * i, b = e >> 7, j = e & 127; shw[((size_t)(l * 3 + sub) * 24 + b) * 5632 + d0 + j] = res[i]; }
    }
    __syncthreads();
}

template <int MODE>
__device__ __forceinline__ void transpose_item(const float* W, int K, int N, bf16* WT, LAS float* scr, int item, int lane) {
    const int nblk = N / 32, kb = item / nblk, nb = item % nblk, k0 = 64 * kb, n0 = 32 * nb;
    const int rbase = MODE == 0 ? n0 : ((n0 >> 7) * 256 + (n0 & 127) + (MODE == 2 ? 128 : 0));
    float wv_[32];
#pragma unroll
    for (int i = 0; i < 32; ++i) wv_[i] = W[(size_t)(k0 + 2 * i + (lane >> 5)) * N + n0 + (lane & 31)];
#pragma unroll
    for (int i = 0; i < 32; ++i) scr[(2 * i + (lane >> 5)) * 33 + (lane & 31)] = wv_[i];
    asm volatile("s_waitcnt lgkmcnt(0)" ::: "memory");
    const int c = lane & 7;
#pragma unroll
    for (int j = 0; j < 4; ++j) { const int n = (lane >> 3) + 8 * j; const LAS float* s = scr + (8 * c) * 33 + n;
        u32x4 o; o.x = pk2(s[0 * 33], s[1 * 33]); o.y = pk2(s[2 * 33], s[3 * 33]); o.z = pk2(s[4 * 33], s[5 * 33]); o.w = pk2(s[6 * 33], s[7 * 33]);
        *(u32x4*)(WT + (size_t)(rbase + n) * K + k0 + 8 * c) = o; }
    asm volatile("s_waitcnt lgkmcnt(0)" ::: "memory");
}
constexpr int I_G = 16 * 88, I_D = 44 * 32, I_IN = 16 * 128, I_OUT = 16 * 32;
constexpr int NW_A = 2 * I_G + I_D + I_IN, NW_B = I_OUT + 2 * I_G + I_D;
__device__ __forceinline__ void weights_item(const Params& p, int l, bool setB, int r, LAS float* scr, int lane) {
    const size_t fsz = (size_t)D * FF;
    if (!setB) {
        if (r < I_G) { transpose_item<1>(p.wg + (size_t)(l * 2 + 0) * fsz, D, FF, (bf16*)(p.ws + WS_WGU0), scr, r, lane); return; } r -= I_G;
        if (r < I_G) { transpose_item<2>(p.wu + (size_t)(l * 2 + 0) * fsz, D, FF, (bf16*)(p.ws + WS_WGU0), scr, r, lane); return; } r -= I_G;
        if (r < I_D) { transpose_item<0>(p.wd + (size_t)(l * 2 + 0) * fsz, FF, D, (bf16*)(p.ws + WS_WD0), scr, r, lane); return; } r -= I_D;
        transpose_item<0>(p.w_in + (size_t)l * D * NPJ, D, NPJ, (bf16*)(p.ws + WS_WIN), scr, r, lane);
    } else {
        if (r < I_OUT) { transpose_item<0>(p.w_out + (size_t)l * D * D, D, D, (bf16*)(p.ws + WS_WOUT), scr, r, lane); return; } r -= I_OUT;
        if (r < I_G) { transpose_item<1>(p.wg + (size_t)(l * 2 + 1) * fsz, D, FF, (bf16*)(p.ws + WS_WGU1), scr, r, lane); return; } r -= I_G;
        if (r < I_G) { transpose_item<2>(p.wu + (size_t)(l * 2 + 1) * fsz, D, FF, (bf16*)(p.ws + WS_WGU1), scr, r, lane); return; } r -= I_G;
        transpose_item<0>(p.wd + (size_t)(l * 2 + 1) * fsz, FF, D, (bf16*)(p.ws + WS_WD1), scr, r, lane);
    }
}
__device__ __forceinline__ void phase_weights_a0(const Params& p, LAS unsigned char* lds, const int tid) {
    const int wave = tid >> 6, lane = tid & 63;
    LAS float* scr = (LAS float*)(lds + wave * 16384);
    const int gw = blockIdx.x * 8 + wave, NGW = gridDim.x * 8;
    for (int it = gw; it < NW_A; it += NGW) weights_item(p, 0, false, it, scr, lane);
}

__device__ __forceinline__ void phase_norm_first(const Params& p, const int tid) {
    const int wave = tid >> 6, lane = tid & 63;
    const int gw = blockIdx.x * 8 + wave, NGW = gridDim.x * 8;
    const f32x4* g4 = (const f32x4*)(p.norm_g) + lane;
    const float* mod = (const float*)(p.ws + WS_MOD);
    bf16* H = (bf16*)(p.ws + WS_H);
    float* ssq = (float*)(p.ws + WS_SSQ);
    for (int row = gw; row < T; row += NGW) {
        const float* xr = row < TP ? p.xp + (size_t)row * D : p.xs + (size_t)(row - TP) * D;
        const int b = batch_of_row(row);
        const f32x4* sc4 = (const f32x4*)(mod + ((size_t)b * 9 + 1) * D) + lane;
        const f32x4* x4 = (const f32x4*)xr + lane;
        f32x4 v[4]; float s = 0.f;
#pragma unroll
        for (int j = 0; j < 4; ++j) { v[j] = x4[64 * j]; s += (v[j].x * v[j].x + v[j].y * v[j].y) + (v[j].z * v[j].z + v[j].w * v[j].w); }
        s = wave_sum(s);
        if (lane == 0) ssq[row] = s;
        u32x2* o8 = (u32x2*)(H + (size_t)row * D) + lane;
#pragma unroll
        for (int j = 0; j < 4; ++j) {
            const f32x4 y = v[j] * g4[64 * j] * (sc4[64 * j] + 1.0f);
            u32x2 w; w.x = pk2(y.x, y.y); w.y = pk2(y.z, y.w);
            o8[64 * j] = w;
        }
    }
}

constexpr int HB_QB = 0, HB_QM = 8704, HB_KM = 17408, HB_KLT = 26112, HB_VT = 36352, HB_AM = 46592, HB_DEC = 49152, HB_TOT = 49664, HB_SIZE = 51712;
__device__ __forceinline__ void hgrn_chain_ws(const Params& p, int l, int ch, LAS unsigned char* lds, const int tid) {
    const int seq = ch >> 3, head = (ch >> 1) & 3, dir = ch & 1;
    const int tb = seq < 16 ? seq * 2048 : TP + (seq - 16) * 4096, L = seq < 16 ? 2048 : 4096;
    bf16* proj = (bf16*)(p.ws + WS_BIG);
    const int cq = head * 128, cf = 512 + dir * 512 + head * 128, ci = 1536 + head * 128;
    const int lane = tid & 63, w = __builtin_amdgcn_readfirstlane(tid >> 6), r16 = lane & 15, g = lane >> 4;
    const int nch = L / 32;
    const char* pbase = (const char*)proj + (size_t)tb * (PJP * 2);
#define WS_CBASE(cn) (pbase + (size_t)(dir ? (L - 32 * ((cn) + 1)) : 32 * (cn)) * (PJP * 2))
    if (w < 4) {
        const int k = tid & 127, th = tid >> 7;
        float lb;
        {
            const float* raw = (dir ? p.lbb : p.lbf) + head * 128 + k;
            const float a0 = raw[0], a1 = raw[512], a2 = raw[1024], a3 = raw[1536];
            const float mx = fmaxf(fmaxf(a0, a1), fmaxf(a2, a3));
            const float e0 = __expf(a0 - mx), e1 = __expf(a1 - mx), e2 = __expf(a2 - mx), e3 = __expf(a3 - mx);
            float num = 0.f; if (l >= 1) num += e1; if (l >= 2) num += e2; if (l >= 3) num += e3;
            lb = num / ((e0 + e1) + (e2 + e3));
        }
        const float oml = 1.0f - lb;
        unsigned voffL[16];
#pragma unroll
        for (int e = 0; e < 16; ++e) { const int rl = dir ? (31 - 16 * th - e) : (16 * th + e); voffL[e] = (unsigned)(rl * (PJP * 2) + k * 2); }
        unsigned rq[16], rf[16], ri[16];
        float q[16], kk[16], bb[16]; unsigned vr[16];
#define WS_LOAD(cn) do { const char* cb_ = WS_CBASE(cn); const char* bq_ = cb_ + cq * 2; const char* bf_ = cb_ + cf * 2; const char* bi_ = cb_ + ci * 2; \
        _Pragma("unroll") for (int e = 0; e < 16; ++e) { rq[e] = *(const unsigned short*)(bq_ + voffL[e]); rf[e] = *(const unsigned short*)(bf_ + voffL[e]); ri[e] = *(const unsigned short*)(bi_ + voffL[e]); } } while (0)
#define WS_P1(cn) do { LAS float* TOT_ = (LAS float*)(lds + ((cn) & 1) * HB_SIZE + HB_TOT); float run_ = 0.f; \
        _Pragma("unroll") for (int e = 0; e < 16; ++e) { const float hf_ = __uint_as_float(rf[e] << 16); q[e] = __uint_as_float(rq[e] << 16); vr[e] = ri[e]; \
            const float f_ = lb + oml * hf_; run_ += fmaxf(__log2f(f_), -7.9f);        bb[e] = run_; kk[e] = 1.0f - f_; } \
        TOT_[th * 128 + k] = run_; } while (0)
#define WS_P2(cn) do { LAS unsigned char* B_ = lds + ((cn) & 1) * HB_SIZE; \
        LAS bf16* QB_ = (LAS bf16*)(B_ + HB_QB); LAS bf16* QM_ = (LAS bf16*)(B_ + HB_QM); LAS bf16* KM_ = (LAS bf16*)(B_ + HB_KM); \
        LAS bf16* KLT_ = (LAS bf16*)(B_ + HB_KLT); LAS bf16* VT_ = (LAS bf16*)(B_ + HB_VT); LAS float* DEC_ = (LAS float*)(B_ + HB_DEC); LAS float* TOT_ = (LAS float*)(B_ + HB_TOT); \
        const float t0 = TOT_[k], t1 = TOT_[128 + k]; \
        const float off = th == 0 ? 0.f : t0; \
        const float bm = t0, b31 = t0 + t1;                                 \
        const float sbm = __builtin_amdgcn_exp2f(bm), s31 = __builtin_amdgcn_exp2f(b31 - bm); \
        float kl[16]; \
        _Pragma("unroll") for (int e = 0; e < 16; e += 2) { const int i = 16 * th + e; \
            const float d0_ = off + bb[e] - bm, d1_ = off + bb[e + 1] - bm; \
            const float qm0 = q[e] * __builtin_amdgcn_exp2f(d0_), qm1 = q[e + 1] * __builtin_amdgcn_exp2f(d1_); \
            const float km0 = kk[e] * __builtin_amdgcn_exp2f(-d0_), km1 = kk[e + 1] * __builtin_amdgcn_exp2f(-d1_); \
            const unsigned wq_ = pk2(qm0, qm1), wk_ = pk2(km0, km1);            \
            QM_[i * 136 + k] = (bf16)(wq_ & 0xffffu); QM_[(i + 1) * 136 + k] = (bf16)(wq_ >> 16); \
            KM_[i * 136 + k] = (bf16)(wk_ & 0xffffu); KM_[(i + 1) * 136 + k] = (bf16)(wk_ >> 16); \
            kl[e] = km0 * s31; kl[e + 1] = km1 * s31; } \
        _Pragma("unroll") for (int h8 = 0; h8 < 2; ++h8) { \
            u32x4 wk; wk.x = pk2(kl[8 * h8 + 0], kl[8 * h8 + 1]); wk.y = pk2(kl[8 * h8 + 2], kl[8 * h8 + 3]); wk.z = pk2(kl[8 * h8 + 4], kl[8 * h8 + 5]); wk.w = pk2(kl[8 * h8 + 6], kl[8 * h8 + 7]); \
            *(LAS u32x4*)(KLT_ + k * 40 + 16 * th + 8 * h8) = wk; \
            u32x4 wv; wv.x = vr[8 * h8 + 0] | (vr[8 * h8 + 1] << 16); wv.y = vr[8 * h8 + 2] | (vr[8 * h8 + 3] << 16); wv.z = vr[8 * h8 + 4] | (vr[8 * h8 + 5] << 16); wv.w = vr[8 * h8 + 6] | (vr[8 * h8 + 7] << 16); \
            *(LAS u32x4*)(VT_ + k * 40 + 16 * th + 8 * h8) = wv; } \
        if (th == 0) { DEC_[k] = __builtin_amdgcn_exp2f(b31); ((LAS float*)(B_ + HB_QB))[k] = sbm; } } while (0)
        WS_LOAD(0);
        WS_P1(0);
        LBAR();
        WS_P2(0);
        WS_LOAD(1);
        WS_P1(1);
        LBAR();
        for (int c = 0; c < nch; ++c) {
            WS_LOAD(min(c + 2, nch - 1));
            WS_P2(c + 1);
            LBAR();
            WS_P1(c + 2);
            LBAR();
        }
#undef WS_LOAD
#undef WS_P1
#undef WS_P2
    } else {
        const int mw = w - 4;
        f32x4 S[8][2];
#pragma unroll
        for (int t = 0; t < 8; ++t) { S[t][0] = (f32x4){0.f, 0.f, 0.f, 0.f}; S[t][1] = S[t][0]; }
        unsigned voffS[2][8];
#pragma unroll
        for (int vt = 0; vt < 2; ++vt)
#pragma unroll
            for (int e = 0; e < 8; ++e) { const int ps = 16 * (e >> 2) + 4 * g + (e & 3), rs_ = dir ? (31 - ps) : ps; voffS[vt][e] = (unsigned)(rs_ * (PJP * 2) + (16 * (2 * mw + vt) + r16) * 2); }
        const int sti = (mw == 1 || mw == 2) ? 1 : 0, stj = (mw >= 2) ? 1 : 0;
        LBAR();
        LBAR();
        for (int c = 0; c < nch; ++c) {
            LAS unsigned char* B = lds + (c & 1) * HB_SIZE;
            LAS bf16* QB = (LAS bf16*)(B + HB_QB); LAS bf16* QM = (LAS bf16*)(B + HB_QM); LAS bf16* KM = (LAS bf16*)(B + HB_KM);
            LAS bf16* KLT = (LAS bf16*)(B + HB_KLT); LAS bf16* VT = (LAS bf16*)(B + HB_VT); LAS bf16* AM = (LAS bf16*)(B + HB_AM);
            LAS float* DEC = (LAS float*)(B + HB_DEC); LAS float* SBM = (LAS float*)(B + HB_QB);
            {
                f32x4 sc = (f32x4){0.f, 0.f, 0.f, 0.f};
#pragma unroll
                for (int s = 0; s < 4; ++s) {
                    const bf16x8 a = *(const LAS bf16x8*)(QM + (16 * sti + r16) * 136 + 32 * s + 8 * g);
                    const bf16x8 b = *(const LAS bf16x8*)(KM + (16 * stj + r16) * 136 + 32 * s + 8 * g);
                    sc = MFMA16(a, b, sc);
                }
#pragma unroll
                for (int r = 0; r < 4; ++r) {
                    const int i = 16 * sti + 4 * g + r, j = 16 * stj + r16;
                    const float val = (j <= i) ? sc[r] : 0.f;
                    AM[i * 40 + j] = (bf16)(pk2(val, 0.f) & 0xffffu);
                }
            }
            f32x4 O[2][2];
#pragma unroll
            for (int ti = 0; ti < 2; ++ti) { O[ti][0] = (f32x4){0.f, 0.f, 0.f, 0.f}; O[ti][1] = O[ti][0]; }
#pragma unroll
            for (int s = 0; s < 4; ++s) {
                bf16x8 bfrag[2];
                const f32x4 m0 = *(const LAS f32x4*)(SBM + 32 * s + 4 * g), m1 = *(const LAS f32x4*)(SBM + 32 * s + 16 + 4 * g);
#pragma unroll
                for (int vt = 0; vt < 2; ++vt) {
                    const f32x4 s0 = S[2 * s][vt] * m0, s1 = S[2 * s + 1][vt] * m1;
                    u32x4 bw; bw.x = pk2(s0[0], s0[1]); bw.y = pk2(s0[2], s0[3]); bw.z = pk2(s1[0], s1[1]); bw.w = pk2(s1[2], s1[3]);
                    bfrag[vt] = __builtin_bit_cast(bf16x8, bw);
                }
#pragma unroll
                for (int ti = 0; ti < 2; ++ti) {
                    const u32x2 lo = *(const LAS u32x2*)(QM + (16 * ti + r16) * 136 + 32 * s + 4 * g);
                    const u32x2 hi = *(const LAS u32x2*)(QM + (16 * ti + r16) * 136 + 32 * s + 16 + 4 * g);
                    u32x4 aw; aw.x = lo.x; aw.y = lo.y; aw.z = hi.x; aw.w = hi.y;
                    const bf16x8 af = __builtin_bit_cast(bf16x8, aw);
                    O[ti][0] = MFMA16(af, bfrag[0], O[ti][0]);
                    O[ti][1] = MFMA16(af, bfrag[1], O[ti][1]);
                }
            }
            bf16x8 vfrag[2];
#pragma unroll
            for (int vt = 0; vt < 2; ++vt) vfrag[vt] = *(const LAS bf16x8*)(VT + (16 * (2 * mw + vt) + r16) * 40 + 8 * g);
#pragma unroll
            for (int t = 0; t < 8; ++t) {
                const f32x4 d4 = *(const LAS f32x4*)(DEC + 16 * t + 4 * g);
                const bf16x8 a = *(const LAS bf16x8*)(KLT + (16 * t + r16) * 40 + 8 * g);
                S[t][0] = MFMA16(a, vfrag[0], S[t][0] * d4);
                S[t][1] = MFMA16(a, vfrag[1], S[t][1] * d4);
            }
            LBAR();
#pragma unroll
            for (int ti = 0; ti < 2; ++ti) {
                const bf16x8 a = *(const LAS bf16x8*)(AM + (16 * ti + r16) * 40 + 8 * g);
                O[ti][0] = MFMA16(a, vfrag[0], O[ti][0]);
                O[ti][1] = MFMA16(a, vfrag[1], O[ti][1]);
            }
            {
                char* sb_ = (char*)WS_CBASE(c) + cf * 2;
#pragma unroll
                for (int vt = 0; vt < 2; ++vt)
#pragma unroll
                    for (int ti = 0; ti < 2; ++ti)
#pragma unroll
                        for (int r = 0; r < 4; ++r) *(unsigned short*)(sb_ + voffS[vt][ti * 4 + r]) = (unsigned short)(pk2(O[ti][vt][r], 0.f) & 0xffffu);
            }
            LBAR();
        }
    }
#undef WS_CBASE
    __syncthreads();
}

constexpr int NA_KS = 0, NA_VT = 73728, NA_RK = 140288, NA_RPB = 142336, NA_END = 144256, NA_XCH = NA_END + 1024;
__device__ __forceinline__ void na_stage_store(const u32x4 kw, const u32x4 vw, int kr, LAS unsigned char* lds, const int tid) {
    const int key = tid >> 3, ch = tid & 7, slot = kr & 7;
    float f[8]; unpack8(kw, f);
    float ss = 0.f;
#pragma unroll
    for (int e = 0; e < 8; ++e) ss += f[e] * f[e];
    ss += __shfl_xor(ss, 1); ss += __shfl_xor(ss, 2); ss += __shfl_xor(ss, 4);
    *(LAS u32x4*)((LAS bf16*)(lds + NA_KS) + (slot * 64 + key) * 72 + ch * 8) = kw;
    if (ch == 0) ((LAS float*)(lds + NA_RK))[slot * 64 + key] = __builtin_amdgcn_rsqf(ss * (1.f / 64.f) + EPS);
    LAS bf16* vt = (LAS bf16*)(lds + NA_VT) + (ch * 8) * 520 + slot * 64 + key;
    vt[0 * 520] = (bf16)(vw.x & 0xffffu); vt[1 * 520] = (bf16)(vw.x >> 16); vt[2 * 520] = (bf16)(vw.y & 0xffffu); vt[3 * 520] = (bf16)(vw.y >> 16);
    vt[4 * 520] = (bf16)(vw.z & 0xffffu); vt[5 * 520] = (bf16)(vw.z >> 16); vt[6 * 520] = (bf16)(vw.w & 0xffffu); vt[7 * 520] = (bf16)(vw.w >> 16);
}
__device__ __forceinline__ void na_unit_mfma(const Params& p, int l, int unit, LAS unsigned char* lds, const int tid) {
    int seq, h, run, rows, seqbase;
    if (unit < 512) { seq = unit >> 5; h = (unit >> 2) & 7; run = unit & 3; rows = 32; seqbase = seq * 2048; }
    else { const int u2 = unit - 512; seq = u2 >> 6; h = (u2 >> 3) & 7; run = u2 & 7; rows = 64; seqbase = TP + seq * 4096; }
    const bf16* proj = (const bf16*)(p.ws + WS_BIG);
    bf16* mix = (bf16*)(p.ws + WS_H);
    const int lane = tid & 63, w = __builtin_amdgcn_readfirstlane(tid >> 6), r16 = lane & 15, g = lane >> 4;
    const int jq = w & 3, hh = w >> 2;
    const int qc = 16 * jq + r16;
    const int kc0 = min(max(16 * jq - 8, 0), 32);
    const int c0 = min(max(qc - 8, 0), 48);
    LAS float* RPB = (LAS float*)(lds + NA_RPB);
    LAS float* RK = (LAS float*)(lds + NA_RK);
    LAS bf16* KS = (LAS bf16*)(lds + NA_KS);
    LAS bf16* VTS = (LAS bf16*)(lds + NA_VT);
    __syncthreads();
    if (tid < 465) RPB[tid] = p.rpb[(size_t)(l * 8 + h) * 465 + tid];
    LAS float* GQK = (LAS float*)(lds + NA_END + 256);
    if (tid < 64) GQK[tid] = p.qng[l * 64 + tid] * p.kng[l * 64 + tid];
    int bidx[8]; unsigned vmask = 0u;
#pragma unroll
    for (int ce = 0; ce < 8; ++ce) {
        const int kc = kc0 + 16 * (ce >> 2) + 4 * g + (ce & 3);
        bidx[ce] = min(max(kc, qc - 15), qc + 15);
        if (kc >= c0 && kc < c0 + 16) vmask |= 1u << ce;
    }
    const bf16* src0 = proj + (size_t)(seqbase + (tid >> 3)) * PJP + 3072 + h * 64 + (tid & 7) * 8;
    const bf16* qsrc0 = proj + (size_t)(seqbase + qc) * PJP + 2560 + h * 64 + 8 * g;
    int staged_hi;
    u32x4 qa, qb, nkw, nvw;
    {
        const int r = run * 8, r0 = min(max(r - 4, 0), rows - 8);
        u32x4 kw[8], vw[8];
#pragma unroll
        for (int i = 0; i < 8; ++i) { const bf16* s_ = src0 + (size_t)(r0 + i) * 64 * PJP; kw[i] = *(const u32x4*)s_; vw[i] = *(const u32x4*)(s_ + 512); }
        qa = *(const u32x4*)(qsrc0 + (size_t)r * 64 * PJP); qb = *(const u32x4*)(qsrc0 + (size_t)r * 64 * PJP + 32);
        __syncthreads();
#pragma unroll
        for (int i = 0; i < 8; ++i) na_stage_store(kw[i], vw[i], r0 + i, lds, tid);
        staged_hi = r0 + 7;
        nkw = kw[0]; nvw = vw[0];
    }
    for (int rq = 0; rq < 8; ++rq) {
        const int r = run * 8 + rq;
        const int r0 = min(max(r - 4, 0), rows - 8);
        LBAR();
        if (r0 + 7 > staged_hi) { na_stage_store(nkw, nvw, r0 + 7, lds, tid); staged_hi = r0 + 7; }
        const int tokq = seqbase + r * 64 + qc;
        bf16x8 qfrag[2];
        {
            float q0[8], q1[8]; unpack8(qa, q0); unpack8(qb, q1);
            float ss = 0.f;
#pragma unroll
            for (int e = 0; e < 8; ++e) ss += q0[e] * q0[e] + q1[e] * q1[e];
            ss += __shfl_xor(ss, 16); ss += __shfl_xor(ss, 32);
            const float rs = 0.125f * __builtin_amdgcn_rsqf(ss * (1.f / 64.f) + EPS);
            float gqk[2][8];
#pragma unroll
            for (int s = 0; s < 2; ++s) { const f32x4 ga = *(const LAS f32x4*)(GQK + 32 * s + 8 * g), gb = *(const LAS f32x4*)(GQK + 32 * s + 8 * g + 4);
                gqk[s][0] = ga[0]; gqk[s][1] = ga[1]; gqk[s][2] = ga[2]; gqk[s][3] = ga[3]; gqk[s][4] = gb[0]; gqk[s][5] = gb[1]; gqk[s][6] = gb[2]; gqk[s][7] = gb[3]; }
            u32x4 a, b;
            a.x = pk2(q0[0] * rs * gqk[0][0], q0[1] * rs * gqk[0][1]); a.y = pk2(q0[2] * rs * gqk[0][2], q0[3] * rs * gqk[0][3]);
            a.z = pk2(q0[4] * rs * gqk[0][4], q0[5] * rs * gqk[0][5]); a.w = pk2(q0[6] * rs * gqk[0][6], q0[7] * rs * gqk[0][7]);
            b.x = pk2(q1[0] * rs * gqk[1][0], q1[1] * rs * gqk[1][1]); b.y = pk2(q1[2] * rs * gqk[1][2], q1[3] * rs * gqk[1][3]);
            b.z = pk2(q1[4] * rs * gqk[1][4], q1[5] * rs * gqk[1][5]); b.w = pk2(q1[6] * rs * gqk[1][6], q1[7] * rs * gqk[1][7]);
            qfrag[0] = __builtin_bit_cast(bf16x8, a); qfrag[1] = __builtin_bit_cast(bf16x8, b);
        }
        LBAR();
        if (rq < 7) {
            const int rn = r + 1, r0n = min(max(rn - 4, 0), rows - 8);
            qa = *(const u32x4*)(qsrc0 + (size_t)rn * 64 * PJP); qb = *(const u32x4*)(qsrc0 + (size_t)rn * 64 * PJP + 32);
            if (r0n + 7 > staged_hi) { const bf16* s_ = src0 + (size_t)(r0n + 7) * 64 * PJP; nkw = *(const u32x4*)s_; nvw = *(const u32x4*)(s_ + 512); }
        }
        f32x4 sc[8];
        float m = -3.0e38f;
#pragma unroll
        for (int r4 = 0; r4 < 4; ++r4) {
            const int rr = 4 * hh + r4;
            const int slot = (r0 + rr) & 7;
            const LAS float* brow = RPB + (r0 + rr - r + 7) * 31 + 15 - qc;
            float bias[8];
#pragma unroll
            for (int ce = 0; ce < 8; ++ce) bias[ce] = brow[bidx[ce]];
#pragma unroll
            for (int ct = 0; ct < 2; ++ct) {
                f32x4 acc = (f32x4){0.f, 0.f, 0.f, 0.f};
                const LAS bf16* kp = KS + (slot * 64 + kc0 + 16 * ct + r16) * 72 + 8 * g;
                acc = MFMA16(*(const LAS bf16x8*)kp, qfrag[0], acc);
                acc = MFMA16(*(const LAS bf16x8*)(kp + 32), qfrag[1], acc);
                const f32x4 rk4 = *(const LAS f32x4*)(RK + slot * 64 + kc0 + 16 * ct + 4 * g);
#pragma unroll
                for (int e = 0; e < 4; ++e) {
                    const float v0 = acc[e] * rk4[e] + bias[ct * 4 + e];
                    const float v = ((vmask >> (ct * 4 + e)) & 1u) ? v0 : -3.0e38f;
                    acc[e] = v; m = fmaxf(m, v);
                }
                sc[r4 * 2 + ct] = acc;
            }
        }
        m = fmaxf(m, __shfl_xor(m, 16)); m = fmaxf(m, __shfl_xor(m, 32));
        float lsum = 0.f;
#pragma unroll
        for (int t = 0; t < 8; ++t)
#pragma unroll
            for (int e = 0; e < 4; ++e) { const float pv = __expf(sc[t][e] - m); sc[t][e] = pv; lsum += pv; }
        lsum += __shfl_xor(lsum, 16); lsum += __shfl_xor(lsum, 32);
        f32x4 O[4];
#pragma unroll
        for (int dt = 0; dt < 4; ++dt) O[dt] = (f32x4){0.f, 0.f, 0.f, 0.f};
#pragma unroll
        for (int r4 = 0; r4 < 4; ++r4) {
            const int slot = (r0 + 4 * hh + r4) & 7;
            u32x4 bw; bw.x = pk2(sc[2 * r4][0], sc[2 * r4][1]); bw.y = pk2(sc[2 * r4][2], sc[2 * r4][3]); bw.z = pk2(sc[2 * r4 + 1][0], sc[2 * r4 + 1][1]); bw.w = pk2(sc[2 * r4 + 1][2], sc[2 * r4 + 1][3]);
            const bf16x8 bfrag = __builtin_bit_cast(bf16x8, bw);
#pragma unroll
            for (int dt = 0; dt < 4; ++dt) {
                const LAS bf16* vp = VTS + (16 * dt + r16) * 520 + slot * 64 + kc0 + 4 * g;
                const u32x2 lo = *(const LAS u32x2*)vp, hi = *(const LAS u32x2*)(vp + 16);
                u32x4 aw; aw.x = lo.x; aw.y = lo.y; aw.z = hi.x; aw.w = hi.y;
                O[dt] = MFMA16(__builtin_bit_cast(bf16x8, aw), bfrag, O[dt]);
            }
        }
        LAS unsigned* X = (LAS unsigned*)(lds + NA_XCH) + jq * 64 + lane;
        if (hh == 1) {
            X[0 * 256] = __float_as_uint(m); X[1 * 256] = __float_as_uint(lsum);
#pragma unroll
            for (int dt = 0; dt < 4; ++dt) { X[(2 + 2 * dt) * 256] = pk2(O[dt][0], O[dt][1]); X[(3 + 2 * dt) * 256] = pk2(O[dt][2], O[dt][3]); }
        }
        LBAR();
        if (hh == 0) {
            const float m1 = __uint_as_float(X[0 * 256]), l1 = __uint_as_float(X[1 * 256]);
            const float mm = fmaxf(m, m1), a0 = __expf(m - mm), a1 = __expf(m1 - mm);
            const float inv = __builtin_amdgcn_rcpf(lsum * a0 + l1 * a1);
            const float c0_ = a0 * inv, c1_ = a1 * inv;
#pragma unroll
            for (int dt = 0; dt < 4; ++dt) {
                const unsigned w0 = X[(2 + 2 * dt) * 256], w1 = X[(3 + 2 * dt) * 256];
                u32x2 ow;
                ow.x = pk2(O[dt][0] * c0_ + bflo(w0) * c1_, O[dt][1] * c0_ + bfhi(w0) * c1_);
                ow.y = pk2(O[dt][2] * c0_ + bflo(w1) * c1_, O[dt][3] * c0_ + bfhi(w1) * c1_);
                *(u32x2*)(mix + (size_t)tokq * D + 512 + h * 64 + 16 * dt + 4 * g) = ow;
            }
        }
    }
}

__device__ __forceinline__ void phase_mixer(const Params& p, int l, LAS unsigned char* lds, const int tid) {
    if (blockIdx.x < 192) hgrn_chain_ws(p, l, blockIdx.x, lds, tid);
    unsigned* ctr = (unsigned*)(p.ws + WS_CTL) + 64 * (l + 1);
    LAS unsigned* sh = (LAS unsigned*)(lds + NA_END);
    const int nwi = NW_B + (l + 1 < DEPTH ? NW_A : 0);
    const unsigned nunits = 1024u + (unsigned)((nwi + 7) / 8);
    for (;;) {
        if (tid == 0) sh[0] = atomicAdd(ctr, 1u);
        __syncthreads();
        const unsigned u = sh[0];
        __syncthreads();
        if (u >= nunits) break;
        if (u < 1024u) na_unit_mfma(p, l, (int)u, lds, tid);
        else {
            const int wave = tid >> 6, lane = tid & 63;
            const int item = (int)(u - 1024u) * 8 + wave;
            LAS float* scr = (LAS float*)(lds + wave * 16384);
            if (item < NW_B) weights_item(p, l, true, item, scr, lane);
            else if (item < nwi) weights_item(p, l + 1, false, item - NW_B, scr, lane);
        }
    }
}

__device__ __forceinline__ void phase_combine(const Params& p, int l, const int tid) {
    const int wave = tid >> 6, lane = tid & 63;
    const int gw = blockIdx.x * 8 + wave, NGW = gridDim.x * 8;
    const bf16* proj = (const bf16*)(p.ws + WS_BIG);
    bf16* mix = (bf16*)(p.ws + WS_H);
    const int col = (lane >> 4) * 128 + (lane & 15) * 8;
    float g[8];
#pragma unroll
    for (int j = 0; j < 8; ++j) g[j] = p.hgn[l * 128 + (lane & 15) * 8 + j];
    for (int tok = gw; tok < T; tok += NGW) {
        const bf16* row = proj + (size_t)tok * PJP;
        float a[8], b[8], hg[8];
        unpack8(*(const u32x4*)(row + 512 + col), a); unpack8(*(const u32x4*)(row + 1024 + col), b); unpack8(*(const u32x4*)(row + 2048 + col), hg);
        float ss = 0.f;
#pragma unroll
        for (int j = 0; j < 8; ++j) { a[j] += b[j]; ss += a[j] * a[j]; }
        ss += __shfl_xor(ss, 1); ss += __shfl_xor(ss, 2); ss += __shfl_xor(ss, 4); ss += __shfl_xor(ss, 8);
        const float rstd = 1.0f / sqrtf(ss * (1.f / 128.f) + EPS);
        float y[8];
#pragma unroll
        for (int j = 0; j < 8; ++j) y[j] = a[j] * rstd * g[j] * hg[j];
        u32x4 w; w.x = pk2(y[0], y[1]); w.y = pk2(y[2], y[3]); w.z = pk2(y[4], y[5]); w.w = pk2(y[6], y[7]);
        *(u32x4*)(mix + (size_t)tok * D + col) = w;
    }
}

#define RLX_AGENT __ATOMIC_RELAXED, __HIP_MEMORY_SCOPE_AGENT
constexpr int CW_BAR = 4096;
#define XB_TMO      128
#define XB_XCNT(j)  (256  + 64 * (j))
#define XB_XSUB(j)  (1280 + 64 * (j))
#define XB_XGEN(j)  (2304 + 64 * (j))
#define XB_TOP      3328
#define XB_TOPGEN   3392
#define XCD_BAR_WORDS 3456
#define XB_SPIN_CAP (1u << 18)

__device__ __forceinline__ unsigned xb_ld(unsigned* p)              { return __hip_atomic_load(p, __ATOMIC_RELAXED, __HIP_MEMORY_SCOPE_AGENT); }
__device__ __forceinline__ unsigned xb_add(unsigned* p, unsigned v) { return __hip_atomic_fetch_add(p, v, __ATOMIC_RELAXED, __HIP_MEMORY_SCOPE_AGENT); }
__device__ __forceinline__ unsigned xb_xcc_id() { return (unsigned)__builtin_amdgcn_s_getreg((3 << 11) | 20) & 0xFu; }
#define XB_SPIN(cond, bar) do { unsigned _sp = 0; while (cond) { __builtin_amdgcn_s_sleep(1); \
    if ((++_sp & 255u) == 0u) { if (xb_ld(&(bar)[XB_TMO])) break; if (_sp > XB_SPIN_CAP) { atomicAdd(&(bar)[XB_TMO], 1u); break; } } } } while (0)

struct XcdBarrier {
    unsigned* bar; unsigned x;
    volatile LAS unsigned* st;
};

__device__ __forceinline__ XcdBarrier xcd_barrier_post(unsigned* bar, volatile LAS unsigned* st) {
    XcdBarrier b; b.bar = bar; b.x = xb_xcc_id(); b.st = st;
    if (threadIdx.x == 0) (void)xb_add(&bar[XB_XCNT(b.x)], 1u);
    return b;
}
__device__ __forceinline__ void xcd_barrier_complete(unsigned* bar, unsigned x, unsigned& nloc, unsigned& nx) {
    const unsigned G = gridDim.x * gridDim.y * gridDim.z;
    unsigned sum, cnt, mine, sp = 0u;
    for (;;) {
        sum = 0u; cnt = 0u; mine = 0u;
#pragma unroll
        for (unsigned j = 0; j < 16; ++j) { const unsigned c = xb_ld(&bar[XB_XCNT(j)]); sum += c; cnt += (c > 0u) ? 1u : 0u; mine = (j == x) ? c : mine; }
        if (sum == G) break;
        __builtin_amdgcn_s_sleep(1);
        if ((++sp & 255u) == 0u) { if (xb_ld(&bar[XB_TMO])) break; if (sp > XB_SPIN_CAP) { atomicAdd(&bar[XB_TMO], 1u); break; } }
    }
    nloc = mine > 0u ? mine : 1u; nx = cnt > 0u ? cnt : 1u;
}

__device__ __forceinline__ void xcd_barrier(const XcdBarrier& b) {
    asm volatile("s_waitcnt vmcnt(0)" ::: "memory");
    __syncthreads();
    if (threadIdx.x == 0) {
        unsigned* bar = b.bar;
        __builtin_amdgcn_s_waitcnt(0);
        unsigned nloc = b.st[0], nx = b.st[1];
        if (nloc == 0u) { xcd_barrier_complete(bar, b.x, nloc, nx); b.st[0] = nloc; b.st[1] = nx; }
        const unsigned old = xb_add(&bar[XB_XSUB(b.x)], 1u);
        const unsigned gen = old / nloc;
        if (old + 1u == (gen + 1u) * nloc) {
            __builtin_amdgcn_fence(__ATOMIC_RELEASE, "agent");
            asm volatile("s_waitcnt vmcnt(0)" ::: "memory");
            const unsigned og = xb_add(&bar[XB_TOP], 1u);
            const unsigned tg = og / nx;
            if (og + 1u == (tg + 1u) * nx) xb_add(&bar[XB_TOPGEN], 1u);
            else XB_SPIN(xb_ld(&bar[XB_TOPGEN]) == tg, bar);
            __builtin_amdgcn_fence(__ATOMIC_ACQUIRE, "agent");
            xb_add(&bar[XB_XGEN(b.x)], 1u);
            asm volatile("s_waitcnt vmcnt(0)" ::: "memory");
        } else {
            XB_SPIN(xb_ld(&bar[XB_XGEN(b.x)]) == gen, bar);
            __builtin_amdgcn_fence(__ATOMIC_ACQUIRE, "agent");
            asm volatile("s_waitcnt vmcnt(0)" ::: "memory");
        }
    }
    __syncthreads();
}

template <class Epi>
__device__ __forceinline__ void run_gemm(LAS unsigned char* lds, const bf16* A, const bf16* Bt, int N, int K, const Epi& E, const int tid) {
    pg8::Gemm g{A, Bt, T, N, K}; pg8::StaticOrder S; S.init(T, N, (int)gridDim.x, (int)blockIdx.x);
    pg8::gemm_phase<Epi, pg8::StaticOrder, true, true>(lds, g, S, E, tid);
}

__global__ void __launch_bounds__(512, 2) fwd_kernel(Params p) {
    extern __shared__ __attribute__((aligned(16))) unsigned char lds_raw[];
    LAS unsigned char* lds = (LAS unsigned char*)lds_raw;
    volatile LAS unsigned* bst = (volatile LAS unsigned*)(lds + NA_END + 64);
    if (threadIdx.x < 4) bst[threadIdx.x] = 0u;
    __syncthreads();
    XcdBarrier bar = xcd_barrier_post((unsigned*)(p.ws + WS_CTL) + CW_BAR, bst);
    for (int ph = p.ph_lo; ph < p.ph_hi; ++ph) {
        if (ph > p.ph_lo) { if (ph == p.ph_lo + 1) cg::this_grid().sync(); else xcd_barrier(bar); }
        int tid = threadIdx.x; asm volatile("" : "+v"(tid));
        if (ph == 0) {
            for (int e = blockIdx.x * 512 + tid; e < 12 * D; e += gridDim.x * 512) ((float*)(p.ws + WS_NG))[e] = p.norm_g[e];
            phase_mod(p, lds, tid); continue; }
        const int l = ph < 2 ? 0 : (ph - 2) / 8, s = ph < 2 ? 0 : (ph - 2) % 8 + 1;
        float* ssq_all = (float*)(p.ws + WS_SSQ);
        const float* shw_all = (const float*)(p.ws + WS_SHW);
        if (s == 0) {
            phase_shw(p, lds, tid); asm volatile("" : "+v"(tid)); phase_weights_a0(p, lds, tid); asm volatile("" : "+v"(tid)); phase_norm_first(p, tid);
        }
        else if (s == 4) phase_mixer(p, l, lds, tid);
        else if (s == 5) phase_combine(p, l, tid);
        else if (s == 1 || s == 7) {
            const int sub = s == 1 ? 0 : 2;
            pg8::EpiSwiGLU E{(bf16*)(p.ws + WS_BIG), ssq_all + (size_t)(l * 3 + sub) * T, shw_all + (size_t)(l * 3 + sub) * 24 * 5632};
            run_gemm(lds, (const bf16*)(p.ws + (s == 1 ? WS_H : WS_H2)), (const bf16*)(p.ws + (s == 1 ? WS_WGU0 : WS_WGU1)), 2 * FF, D, E, tid);
        } else if (s == 3) {
            pg8::EpiProj E{(bf16*)(p.ws + WS_BIG), ssq_all + (size_t)(l * 3 + 1) * T, shw_all + (size_t)(l * 3 + 1) * 24 * 5632};
            run_gemm(lds, (const bf16*)(p.ws + WS_H), (const bf16*)(p.ws + WS_WIN), NPJ, D, E, tid);
        } else {
            const int sub = s == 2 ? 0 : (s == 6 ? 1 : 2);
            pg8::EpiRes E{p.xp, p.xs, p.out, p.ws, l, sub, ((l == 0) && s == 2) ? 1 : 0};
            const bf16* A = (const bf16*)(p.ws + (s == 6 ? WS_H : WS_BIG));
            const bf16* Bt = (const bf16*)(p.ws + (s == 2 ? WS_WD0 : (s == 6 ? WS_WOUT : WS_WD1)));
            run_gemm(lds, A, Bt, D, s == 6 ? D : FF, E, tid);
        }
    }
}

#ifndef N_LAUNCH_MODE
#define N_LAUNCH_MODE 1
#endif

extern "C" void kernel_launch(void* const* d_in, const int* in_sizes, int n_in, void* d_out, int out_size, void* d_ws, size_t ws_size, hipStream_t stream) {
    static int grid = 0;
    if (grid == 0) {
        if (n_in != 18 || out_size != T * D || ws_size < WS_END) { fprintf(stderr, "kernel_launch: unexpected shapes (n_in %d out %d ws %zu)\n", n_in, out_size, ws_size); grid = -1; return; }
        int dev = 0, cus = 0, per_cu = 0;
        hipGetDevice(&dev);
        hipDeviceGetAttribute(&cus, hipDeviceAttributeMultiprocessorCount, dev);
        if (hipFuncSetAttribute((const void*)fwd_kernel, hipFuncAttributeMaxDynamicSharedMemorySize, LDS_BYTES) != hipSuccess) { fprintf(stderr, "kernel_launch: hipFuncSetAttribute failed\n"); grid = -1; return; }
        if (hipOccupancyMaxActiveBlocksPerMultiprocessor(&per_cu, (const void*)fwd_kernel, 512, LDS_BYTES) != hipSuccess || per_cu < 1) { fprintf(stderr, "kernel_launch: occupancy query says %d\n", per_cu); per_cu = 1; }
        (void)hipGetLastError();
        grid = cus;
    }
    if (grid < 0) return;
    hipMemsetAsync((char*)d_ws + WS_CTL, 0, CTL_BYTES, stream);
    Params p{};
    p.xp = (const float*)d_in[0]; p.xs = (const float*)d_in[1]; p.cp = (const float*)d_in[2]; p.cs = (const float*)d_in[3];
    p.w_mod = (const float*)d_in[4]; p.b_mod = (const float*)d_in[5]; p.norm_g = (const float*)d_in[6];
    p.wg = (const float*)d_in[7]; p.wu = (const float*)d_in[8]; p.wd = (const float*)d_in[9];
    p.w_in = (const float*)d_in[10]; p.w_out = (const float*)d_in[11]; p.lbf = (const float*)d_in[12]; p.lbb = (const float*)d_in[13];
    p.hgn = (const float*)d_in[14]; p.qng = (const float*)d_in[15]; p.kng = (const float*)d_in[16]; p.rpb = (const float*)d_in[17];
    p.out = (float*)d_out; p.ws = (unsigned char*)d_ws;
#if N_LAUNCH_MODE == 1
    p.ph_lo = 0; p.ph_hi = NPHASE;
    void* args[] = {&p};
    hipError_t e = hipLaunchCooperativeKernel((const void*)fwd_kernel, dim3(grid), dim3(512), args, LDS_BYTES, stream);
    if (e != hipSuccess) fprintf(stderr, "cooperative launch failed: %s (grid %d)\n", hipGetErrorString(e), grid);
#else
    for (int ph = 0; ph < NPHASE; ++ph) {
        p.ph_lo = ph; p.ph_hi = ph + 1;
        hipLaunchKernelGGL(fwd_kernel, dim3(grid), dim3(512), LDS_BYTES, stream, p);
    }
#endif
}
```

```cpp
#include <hip/hip_runtime.h>
#include <hip/hip_cooperative_groups.h>
#include <cstdio>
#include <cstdint>
namespace cg = cooperative_groups;
namespace pg8 {
#define PG8_LAS __attribute__((address_space(3)))
typedef unsigned short bf16_t;
typedef short bf16x8 __attribute__((ext_vector_type(8)));
typedef float f32x4 __attribute__((ext_vector_type(4)));
typedef unsigned u32x4 __attribute__((ext_vector_type(4)));
constexpr int BM = 256, BK = 64, HALF = 128, HTB = HALF * BK * 2  , STAGE_BYTES = 8 * HTB, NXCD = 8, WGM = 8;

__host__ __device__ __forceinline__ int lds_byte(int r, int c) { const int st = (r >> 4) * 2 + (c >> 5), rr = r & 15, cc = c & 31, ob = rr * 64 + cc * 2; return st * 1024 + (ob ^ (((ob >> 9) & 1) << 5)); }
__host__ __device__ __forceinline__ void stage_rc(int b, int& R, int& C) { const int st = b / 1024, sb = b % 1024, swz = sb ^ (((sb >> 9) & 1) << 5); R = (st >> 1) * 16 + swz / 64; C = (st & 1) * 32 + (swz % 64) / 2; }
__host__ __device__ __forceinline__ int perm32(int rho) { const int n = rho >> 4, i = rho & 15; return 8 * (i >> 2) + 4 * n + (i & 3); }

struct Unit { int pm, pn; };
struct Gemm { const bf16_t* A; const bf16_t* Bt; int M, N, K; };

struct StaticOrder {
    int nM, nN, nwg, G, c;
    __host__ __device__ void init(int M, int N, int G_, int c_) { nM = M / BM; nN = N / BM; nwg = nM * nN; G = G_; c = c_; }
    __host__ __device__ bool next(int i, Unit& u) const {
        const long L = (long)i * G + c; if (L >= nwg) return false;
        int wgid = (int)L; { const int q = nwg / NXCD, r = nwg % NXCD, xcd = wgid % NXCD, off = wgid / NXCD; wgid = (xcd < r ? xcd * (q + 1) : r * (q + 1) + (xcd - r) * q) + off; }
        const int nig = WGM * nN, gid = wgid / nig, fm = gid * WGM, gsz = (nM - fm) < WGM ? (nM - fm) : WGM;
        u.pm = fm + ((wgid % nig) % gsz); u.pn = (wgid % nig) / gsz; return true;
    }
    __device__ __forceinline__ void a_ready(const Unit&) const {}
    __device__ __forceinline__ void done(const Unit&) const {}
};

__device__ __forceinline__ unsigned cvt_pk_bf16(float lo, float hi) { unsigned r; asm volatile("v_cvt_pk_bf16_f32 %0, %1, %2" : "=v"(r) : "v"(lo), "v"(hi)); return r; }
typedef float f32x2 __attribute__((ext_vector_type(2)));
__device__ __forceinline__ f32x2 gelu_pk(f32x2 v) {
    const f32x2 av = __builtin_elementwise_abs(v), d = av * 0.2316418882f + 1.0f;
    f32x2 t; t.x = __builtin_amdgcn_rcpf(d.x); t.y = __builtin_amdgcn_rcpf(d.y);
    f32x2 q = t * 0.5307027145f + (-0.7265760135f); q = q * t + 0.7107068705f; q = q * t + (-0.142248368f); q = q * t + 0.127414796f; q = q * t;
    const f32x2 s = (v * v) * (-0.72134752044f);
    f32x2 e; e.x = __builtin_amdgcn_exp2f(s.x); e.y = __builtin_amdgcn_exp2f(s.y);
    const f32x2 m = v * (q * e), r = v - m;
    f32x2 o; o.x = v.x < 0.f ? m.x : r.x; o.y = v.y < 0.f ? m.y : r.y; return o;
}

template <int ACT  > struct EpiBf16 {
    static constexpr bool PERM = true, AFTER_DRAIN = false; static_assert(ACT == 0 || ACT == 1, "EpiBf16: ACT is 0 (none) or 1 (gelu_pk)");
    bf16_t* O; int ldc; const float* bias; int split_cols; size_t split_stride; float scale0;
    __device__ __forceinline__ void operator()(const f32x4 (&acc)[2][2][4][2], const Unit& u, int wr, int wc, int fr, int fq) const {
        const int row0 = u.pm * BM + wr * 64 + fr; int colt = u.pn * BM; bf16_t* base = O;
        float sc = 1.f; if (split_cols) { const int t = colt / split_cols; base += (size_t)t * split_stride; colt -= t * split_cols; if (t == 0) sc = scale0; }
        const int col0 = colt + wc * 32 + 8 * fq, bcol0 = u.pn * BM + wc * 32 + 8 * fq;
        f32x4 bv[2][2];
#pragma unroll
        for (int bj = 0; bj < 2; ++bj)
#pragma unroll
            for (int n = 0; n < 2; ++n) bv[bj][n] = bias ? *(const f32x4*)(bias + bcol0 + bj * HALF + 4 * n) : (f32x4){0.f, 0.f, 0.f, 0.f};
#pragma unroll
        for (int ai = 0; ai < 2; ++ai)
#pragma unroll
            for (int m = 0; m < 4; ++m) { bf16_t* rowp = base + (size_t)(row0 + ai * HALF + m * 16) * ldc + col0;
#pragma unroll
                for (int bj = 0; bj < 2; ++bj) { f32x4 v0 = acc[ai][bj][m][0] + bv[bj][0], v1 = acc[ai][bj][m][1] + bv[bj][1];
                    if (ACT == 1) { f32x2 a = gelu_pk((f32x2){v0[0], v0[1]}), b = gelu_pk((f32x2){v0[2], v0[3]}), c = gelu_pk((f32x2){v1[0], v1[1]}), d = gelu_pk((f32x2){v1[2], v1[3]});
                        v0 = (f32x4){a.x, a.y, b.x, b.y}; v1 = (f32x4){c.x, c.y, d.x, d.y}; }
                    v0 = v0 * sc; v1 = v1 * sc; u32x4 w; w.x = cvt_pk_bf16(v0[0], v0[1]); w.y = cvt_pk_bf16(v0[2], v0[3]); w.z = cvt_pk_bf16(v1[0], v1[1]); w.w = cvt_pk_bf16(v1[2], v1[3]);
                    *(u32x4*)(rowp + bj * HALF) = w; } }
    }
};
template <class Epi, class Sched, bool ALIGN_EPI = false, bool SP2 = false>
__device__ __forceinline__ void gemm_phase(PG8_LAS unsigned char* lds, const Gemm g, const Sched& S, const Epi& E, const int tid_in) {
    const int tid = tid_in, wid = __builtin_amdgcn_readfirstlane(tid >> 6), lane = tid & 63, wr = wid >> 2, wc = wid & 3, fr = lane & 15, fq = lane >> 4;
    const int K = g.K, nt = K / BK;
    unsigned voffA[2], voffB[2];
#pragma unroll
    for (int i = 0; i < 2; ++i) { int R, C; stage_rc(tid * 16 + i * 8192, R, C); const int Rb = Epi::PERM ? ((R & ~31) + perm32(R & 31)) : R;
        voffA[i] = (unsigned)(R * K + C) * 2u; voffB[i] = (unsigned)(Rb * K + C) * 2u; }
    const size_t kstep = (size_t)(BK * 2);
    const size_t hstep = (size_t)HALF * K * 2;
    const size_t tstep = 2 * hstep;
    const unsigned ldsw = (unsigned)wid * 1024u;
    const int aoff = lds_byte(wr * 64 + fr, fq * 8), boff = lds_byte(wc * 32 + fr, fq * 8);
#define PG8_SA(b, h) (((b) * 2 + (h)) * HTB)
#define PG8_SB(b, h) ((4 + (b) * 2 + (h)) * HTB)
#define PG8_STAGE(bufoff, gbase, voff) do { _Pragma("unroll") for (int _i = 0; _i < 2; ++_i) \
        __builtin_amdgcn_global_load_lds((const unsigned*)((const char*)(gbase) + (voff)[_i]), (PG8_LAS unsigned*)(lds + (bufoff) + ldsw + _i * 8192), 16, 0, 0); } while (0)
#define PG8_LDA(dst, b, h) do { _Pragma("unroll") for (int m = 0; m < 4; ++m) _Pragma("unroll") for (int k = 0; k < 2; ++k) dst[m][k] = *(const PG8_LAS bf16x8*)(lds + PG8_SA(b, h) + aoff + m * 2048 + k * 1024); } while (0)
#define PG8_LDB(dst, b, h) do { _Pragma("unroll") for (int n = 0; n < 2; ++n) _Pragma("unroll") for (int k = 0; k < 2; ++k) dst[n][k] = *(const PG8_LAS bf16x8*)(lds + PG8_SB(b, h) + boff + n * 2048 + k * 1024); } while (0)
#define PG8_MMA(ai, bj, At, Bt) do { __builtin_amdgcn_s_setprio(1); _Pragma("unroll") for (int m = 0; m < 4; ++m) _Pragma("unroll") for (int n = 0; n < 2; ++n) _Pragma("unroll") for (int k = 0; k < 2; ++k) \
        acc[ai][bj][m][n] = __builtin_amdgcn_mfma_f32_16x16x32_bf16(Bt[n][k], At[m][k], acc[ai][bj][m][n], 0, 0, 0); __builtin_amdgcn_s_setprio(0); } while (0)
#define PG8_WAIT_V(n) asm volatile("s_waitcnt vmcnt(" #n ")" ::: "memory")
#define PG8_WAIT_L(n) asm volatile("s_waitcnt lgkmcnt(" #n ")" ::: "memory")
#define PG8_BAR __builtin_amdgcn_s_barrier()
#define PG8_SCHED __builtin_amdgcn_sched_barrier(0)
    Unit cur, nxt; int ui = 0;
    if (!S.next(0, cur)) return;
    f32x4 acc[2][2][4][2];
#pragma unroll
    for (int a = 0; a < 2; ++a)
#pragma unroll
        for (int b = 0; b < 2; ++b)
#pragma unroll
            for (int m = 0; m < 4; ++m)
#pragma unroll
                for (int n = 0; n < 2; ++n) acc[a][b][m][n] = (f32x4){0.f, 0.f, 0.f, 0.f};
    bf16x8 At[4][2], B0[2][2], B1[2][2];
    const char* cA = (const char*)g.A + (size_t)cur.pm * tstep; const char* cB = (const char*)g.Bt + (size_t)cur.pn * tstep;
    S.a_ready(cur);
    if constexpr (SP2) {
        PG8_STAGE(PG8_SB(0, 0), cB, voffB); PG8_STAGE(PG8_SB(0, 1), cB + hstep, voffB); PG8_STAGE(PG8_SA(0, 0), cA, voffA); PG8_STAGE(PG8_SA(0, 1), cA + hstep, voffA);
        if (wr == 1) PG8_BAR;
        PG8_WAIT_V(2); PG8_BAR;
        PG8_STAGE(PG8_SB(1, 0), cB + kstep, voffB); PG8_STAGE(PG8_SA(1, 0), cA + kstep, voffA); PG8_STAGE(PG8_SB(1, 1), cB + hstep + kstep, voffB);
        PG8_WAIT_V(6); PG8_BAR;
    } else {
        PG8_STAGE(PG8_SB(0, 0), cB, voffB); PG8_STAGE(PG8_SA(0, 0), cA, voffA); PG8_STAGE(PG8_SB(0, 1), cB + hstep, voffB); PG8_STAGE(PG8_SA(0, 1), cA + hstep, voffA);
        if (wr == 1) PG8_BAR;
        PG8_WAIT_V(4); PG8_BAR;
        PG8_STAGE(PG8_SB(1, 0), cB + kstep, voffB); PG8_STAGE(PG8_SA(1, 0), cA + kstep, voffA); PG8_STAGE(PG8_SB(1, 1), cB + hstep + kstep, voffB);
        PG8_WAIT_V(6); PG8_BAR;
    }
    for (;;) {
        const bool has_next = S.next(ui + 1, nxt);
        const char* nA = has_next ? (const char*)g.A + (size_t)nxt.pm * tstep : cA; const char* nB = has_next ? (const char*)g.Bt + (size_t)nxt.pn * tstep : cB;
        for (int t = 0; t < nt; t += 2) {
            const bool last = (t == nt - 2);
            const char* a1 = cA + (size_t)(t + 1) * kstep;
            const char* a2 = last ? nA : cA + (size_t)(t + 2) * kstep; const char* b2 = last ? nB : cB + (size_t)(t + 2) * kstep;
            const char* a3 = a2 + kstep; const char* b3 = b2 + kstep;
            if (last && has_next) S.a_ready(nxt);
            if constexpr (SP2) {
            PG8_LDB(B0, 0, 0); PG8_LDB(B1, 0, 1); PG8_SCHED; PG8_LDA(At, 0, 0); PG8_STAGE(PG8_SA(1, 1), a1 + hstep, voffA);
            PG8_WAIT_V(8); PG8_WAIT_L(0); PG8_BAR; PG8_MMA(0, 0, At, B0); PG8_MMA(0, 1, At, B1); PG8_BAR; PG8_SCHED;
            PG8_LDA(At, 0, 1); PG8_STAGE(PG8_SB(0, 0), b2, voffB); PG8_STAGE(PG8_SB(0, 1), b2 + hstep, voffB); PG8_STAGE(PG8_SA(0, 0), a2, voffA);
            PG8_WAIT_V(8); PG8_WAIT_L(0); PG8_BAR; PG8_MMA(1, 0, At, B0); PG8_MMA(1, 1, At, B1); PG8_BAR; PG8_SCHED;
            PG8_LDB(B0, 1, 0); PG8_LDB(B1, 1, 1); PG8_SCHED; PG8_LDA(At, 1, 0); PG8_STAGE(PG8_SA(0, 1), a2 + hstep, voffA);
            PG8_WAIT_V(8); PG8_WAIT_L(0); PG8_BAR; PG8_MMA(0, 0, At, B0); PG8_MMA(0, 1, At, B1); PG8_BAR; PG8_SCHED;
            PG8_LDA(At, 1, 1); PG8_STAGE(PG8_SB(1, 0), b3, voffB); PG8_STAGE(PG8_SB(1, 1), b3 + hstep, voffB); PG8_STAGE(PG8_SA(1, 0), a3, voffA);
            PG8_WAIT_V(8); PG8_WAIT_L(0); PG8_BAR; PG8_MMA(1, 0, At, B0); PG8_MMA(1, 1, At, B1); PG8_BAR; PG8_SCHED;
            } else {
            PG8_LDB(B0, 0, 0); PG8_SCHED; PG8_LDA(At, 0, 0); PG8_STAGE(PG8_SA(1, 1), a1 + hstep, voffA);
            PG8_WAIT_L(8); PG8_BAR; PG8_WAIT_L(0); PG8_MMA(0, 0, At, B0); PG8_BAR; PG8_SCHED;
            PG8_LDB(B1, 0, 1); PG8_STAGE(PG8_SB(0, 0), b2, voffB);
            PG8_BAR; PG8_WAIT_L(0); PG8_MMA(0, 1, At, B1); PG8_BAR;
            PG8_LDA(At, 0, 1); PG8_STAGE(PG8_SA(0, 0), a2, voffA);
            PG8_BAR; PG8_WAIT_L(0); PG8_MMA(1, 0, At, B0); PG8_BAR; PG8_SCHED;
            PG8_STAGE(PG8_SB(0, 1), b2 + hstep, voffB);
            PG8_WAIT_V(6); PG8_BAR; PG8_MMA(1, 1, At, B1); PG8_BAR;
            PG8_LDB(B0, 1, 0); PG8_SCHED; PG8_LDA(At, 1, 0); PG8_STAGE(PG8_SA(0, 1), a2 + hstep, voffA);
            PG8_WAIT_L(8); PG8_BAR; PG8_WAIT_L(0); PG8_MMA(0, 0, At, B0); PG8_BAR; PG8_SCHED;
            PG8_LDB(B1, 1, 1); PG8_STAGE(PG8_SB(1, 0), b3, voffB);
            PG8_BAR; PG8_WAIT_L(0); PG8_MMA(0, 1, At, B1); PG8_BAR;
            PG8_LDA(At, 1, 1); PG8_STAGE(PG8_SA(1, 0), a3, voffA);
            PG8_BAR; PG8_WAIT_L(0); PG8_MMA(1, 0, At, B0); PG8_BAR; PG8_SCHED;
            PG8_STAGE(PG8_SB(1, 1), b3 + hstep, voffB);
            PG8_WAIT_V(6); PG8_BAR; PG8_MMA(1, 1, At, B1); PG8_BAR;
            }
        }
        if constexpr (ALIGN_EPI) { if (wr == 0) PG8_BAR; }
        if constexpr (!Epi::AFTER_DRAIN) { E(acc, cur, wr, wc, fr, fq); S.done(cur); }
        if (!has_next) break;
#pragma unroll
        for (int a = 0; a < 2; ++a)
#pragma unroll
            for (int b = 0; b < 2; ++b)
#pragma unroll
                for (int m = 0; m < 4; ++m)
#pragma unroll
                    for (int n = 0; n < 2; ++n) acc[a][b][m][n] = (f32x4){0.f, 0.f, 0.f, 0.f};
        cur = nxt; cA = nA; cB = nB; ++ui;
        if constexpr (ALIGN_EPI) { if (wr == 1) PG8_BAR; }
    }
    PG8_WAIT_V(0);
    if constexpr (!ALIGN_EPI) { if (wr == 0) PG8_BAR; }
    PG8_BAR;
    if constexpr (Epi::AFTER_DRAIN) { E.fused(acc, cur, wr, wc, fr, fq, lds, wid, lane); S.done(cur); }
#undef PG8_SA
#undef PG8_SB
#undef PG8_STAGE
#undef PG8_LDA
#undef PG8_LDB
#undef PG8_MMA
#undef PG8_WAIT_V
#undef PG8_WAIT_L
#undef PG8_BAR
#undef PG8_SCHED
}
}

namespace pg8 {
__device__ __forceinline__ float silu_f(float g) { return g * __builtin_amdgcn_rcpf(1.0f + __expf(-g)); }
__device__ __forceinline__ float sigm_f(float g) { return __builtin_amdgcn_rcpf(1.0f + __expf(-g)); }
struct EpiSwiGLU {
    static constexpr bool PERM = true, AFTER_DRAIN = false;
    bf16_t* O; const float* ssq; const float* shw;
    __device__ __forceinline__ void operator()(const f32x4 (&acc)[2][2][4][2], const Unit& u, int wr, int wc, int fr, int fq) const {
        const int r00 = u.pm * BM;
        const int b = r00 < 32768 ? (r00 >> 11) : 16 + ((r00 - 32768) >> 12);
        const int row0 = r00 + wr * 64 + fr; const int col0 = u.pn * 128 + wc * 32 + 8 * fq;
        const float* sp = shw + (size_t)b * 5632 + u.pn * BM + wc * 32 + 8 * fq;
        const f32x4 sg0 = *(const f32x4*)(sp), sg1 = *(const f32x4*)(sp + 4), su0 = *(const f32x4*)(sp + HALF), su1 = *(const f32x4*)(sp + HALF + 4);
#pragma unroll
        for (int ai = 0; ai < 2; ++ai)
#pragma unroll
            for (int m = 0; m < 4; ++m) {
                const int row = row0 + ai * HALF + m * 16;
                const float rs = __builtin_amdgcn_rsqf(ssq[row] * (1.0f / 1024.0f) + 1e-6f);
                bf16_t* rowp = O + (size_t)row * 2816 + col0;
                const f32x4 g0 = acc[ai][0][m][0] * rs + sg0, g1 = acc[ai][0][m][1] * rs + sg1, u0 = acc[ai][1][m][0] * rs + su0, u1 = acc[ai][1][m][1] * rs + su1;
                u32x4 w;
                w.x = cvt_pk_bf16(silu_f(g0[0]) * u0[0], silu_f(g0[1]) * u0[1]);
                w.y = cvt_pk_bf16(silu_f(g0[2]) * u0[2], silu_f(g0[3]) * u0[3]);
                w.z = cvt_pk_bf16(silu_f(g1[0]) * u1[0], silu_f(g1[1]) * u1[1]);
                w.w = cvt_pk_bf16(silu_f(g1[2]) * u1[2], silu_f(g1[3]) * u1[3]);
                *(u32x4*)rowp = w;
            }
    }
};
struct EpiProj {
    static constexpr bool PERM = true, AFTER_DRAIN = false;
    bf16_t* O; const float* ssq; const float* shw;
    __device__ __forceinline__ void operator()(const f32x4 (&acc)[2][2][4][2], const Unit& u, int wr, int wc, int fr, int fq) const {
        const int r00 = u.pm * BM;
        const int b = r00 < 32768 ? (r00 >> 11) : 16 + ((r00 - 32768) >> 12);
        const int row0 = r00 + wr * 64 + fr; const int col0 = u.pn * BM + wc * 32 + 8 * fq;
        const int mode = (u.pn < 2 || u.pn == 8 || u.pn == 9) ? 1 : ((u.pn >= 2 && u.pn < 6) ? 2 : 0);
        const float* sp = shw + (size_t)b * 5632 + col0;
        f32x4 sv[2][2];
#pragma unroll
        for (int bj = 0; bj < 2; ++bj) { sv[bj][0] = *(const f32x4*)(sp + bj * HALF); sv[bj][1] = *(const f32x4*)(sp + bj * HALF + 4); }
#pragma unroll
        for (int ai = 0; ai < 2; ++ai)
#pragma unroll
            for (int m = 0; m < 4; ++m) { const int row = row0 + ai * HALF + m * 16;
                const float rs = __builtin_amdgcn_rsqf(ssq[row] * (1.0f / 1024.0f) + 1e-6f);
                bf16_t* rowp = O + (size_t)row * 4224 + col0;
#pragma unroll
                for (int bj = 0; bj < 2; ++bj) { f32x4 v0 = acc[ai][bj][m][0] * rs + sv[bj][0], v1 = acc[ai][bj][m][1] * rs + sv[bj][1];
                    if (mode == 1) {
#pragma unroll
                        for (int e = 0; e < 4; ++e) { v0[e] = silu_f(v0[e]); v1[e] = silu_f(v1[e]); }
                    } else if (mode == 2) {
#pragma unroll
                        for (int e = 0; e < 4; ++e) { v0[e] = sigm_f(v0[e]); v1[e] = sigm_f(v1[e]); }
                    }
                    u32x4 w; w.x = cvt_pk_bf16(v0[0], v0[1]); w.y = cvt_pk_bf16(v0[2], v0[3]); w.z = cvt_pk_bf16(v1[0], v1[1]); w.w = cvt_pk_bf16(v1[2], v1[3]);
                    *(u32x4*)(rowp + bj * HALF) = w; } }
    }
};
struct EpiRes {
    static constexpr bool PERM = true, AFTER_DRAIN = false;
    const float* xp; const float* xs; float* out; unsigned char* ws;
    int l, sub, fx;
    __device__ __forceinline__ void operator()(const f32x4 (&acc)[2][2][4][2], const Unit& u, int wr, int wc, int fr, int fq) const {
        constexpr size_t kMiB = 1u << 20;
        const int r00 = u.pm * BM;
        const int b = r00 < 32768 ? (r00 >> 11) : 16 + ((r00 - 32768) >> 12);
        const float* mod = (const float*)(ws + 4 * kMiB);
        const float* gp = mod + ((size_t)(l * 24 + b) * 9 + sub * 3 + 2) * 1024;
        const float coef = sub == 1 ? 1.0f : 0.5f;
        const int nl = sub == 2 ? l + 1 : l, nsub = sub == 2 ? 0 : sub + 1;
        const bool has_next = nl < 4;
        const int nidx = has_next ? nl * 3 + nsub : 0;
        bf16_t* Hn = (bf16_t*)(ws + (sub == 1 ? 576 : 64) * kMiB);
        float* ssqn = (float*)(ws + 1 * kMiB) + (size_t)nidx * 65536;
        const float* ng = (const float*)(ws + 7 * kMiB + 768 * 1024) + (size_t)nidx * 1024;
        const float* nsc = mod + ((size_t)((has_next ? nl : 0) * 24 + b) * 9 + nsub * 3 + 1) * 1024;
        const int col0 = u.pn * BM + wc * 32 + 8 * fq;
        f32x4 gv[2][2], hm[2][2];
#pragma unroll
        for (int bj = 0; bj < 2; ++bj)
#pragma unroll
            for (int n = 0; n < 2; ++n) {
                gv[bj][n] = *(const f32x4*)(gp + col0 + bj * HALF + n * 4) * coef;
                hm[bj][n] = *(const f32x4*)(ng + col0 + bj * HALF + n * 4) * (*(const f32x4*)(nsc + col0 + bj * HALF + n * 4) + 1.0f);
            }
        const float* base = fx ? ((r00 < 32768) ? xp : xs - (size_t)32768 * 1024) : out;
#pragma unroll
        for (int ai = 0; ai < 2; ++ai)
#pragma unroll
            for (int m = 0; m < 4; ++m) {
                const int row = r00 + ai * HALF + wr * 64 + m * 16 + fr;
                const size_t off = (size_t)row * 1024 + col0;
                float sq = 0.f;
#pragma unroll
                for (int bj = 0; bj < 2; ++bj) {
                    const f32x4 x0 = *(const f32x4*)(base + off + bj * HALF), x1 = *(const f32x4*)(base + off + bj * HALF + 4);
                    const f32x4 o0 = x0 + gv[bj][0] * acc[ai][bj][m][0], o1 = x1 + gv[bj][1] * acc[ai][bj][m][1];
                    *(f32x4*)(out + off + bj * HALF) = o0; *(f32x4*)(out + off + bj * HALF + 4) = o1;
                    if (has_next) {
                        sq += ((o0[0] * o0[0] + o0[1] * o0[1]) + (o0[2] * o0[2] + o0[3] * o0[3])) + ((o1[0] * o1[0] + o1[1] * o1[1]) + (o1[2] * o1[2] + o1[3] * o1[3]));
                        const f32x4 h0 = o0 * hm[bj][0], h1 = o1 * hm[bj][1];
                        u32x4 w; w.x = cvt_pk_bf16(h0[0], h0[1]); w.y = cvt_pk_bf16(h0[2], h0[3]); w.z = cvt_pk_bf16(h1[0], h1[1]); w.w = cvt_pk_bf16(h1[2], h1[3]);
                        *(u32x4*)(Hn + off + bj * HALF) = w;
                    }
                }
                if (has_next) {
                    sq += __shfl_xor(sq, 16); sq += __shfl_xor(sq, 32);
                    if (fq == 0) unsafeAtomicAdd(ssqn + row, sq);
                }
            }
    }
};
}

#define LAS __attribute__((address_space(3)))
typedef unsigned short bf16;
typedef unsigned u32x4 __attribute__((ext_vector_type(4)));
typedef unsigned u32x2 __attribute__((ext_vector_type(2)));
typedef float f32x4 __attribute__((ext_vector_type(4)));
constexpr int D = 1024, T = 65536, TP = 32768, FF = 2816, NPJ = 4096, DEPTH = 4, NB = 24;
constexpr int PJP = 4096 + 128;
constexpr float EPS = 1e-6f;
constexpr size_t MiB = 1u << 20;
constexpr size_t WS_CTL = 0, CTL_BYTES = 4 * MiB;
constexpr size_t WS_SSQ = 1 * MiB;
constexpr size_t WS_MOD = 4 * MiB;
constexpr size_t WS_NG = 7 * MiB + 768 * 1024;
constexpr size_t WS_SHW = 8 * MiB;
constexpr size_t WS_WGU0 = 16 * MiB, WS_WGU1 = 27 * MiB, WS_WD0 = 38 * MiB, WS_WD1 = 44 * MiB, WS_WIN = 50 * MiB, WS_WOUT = 58 * MiB;
constexpr size_t WS_H = 64 * MiB;
constexpr size_t WS_BIG = 192 * MiB;
constexpr size_t WS_H2 = 576 * MiB;
constexpr size_t WS_END = 720 * MiB;
constexpr int LDS_BYTES = 158720;
constexpr int NPHASE = 2 + 8 * DEPTH;

struct Params {
    const float *xp, *xs, *cp, *cs, *w_mod, *b_mod, *norm_g, *wg, *wu, *wd, *w_in, *w_out, *lbf, *lbb, *hgn, *qng, *kng, *rpb;
    float* out; unsigned char* ws;
    int ph_lo, ph_hi;
};

__device__ __forceinline__ unsigned f2bf(float f) { unsigned u = __builtin_bit_cast(unsigned, f); return (u + 0x7fffu + ((u >> 16) & 1u)) >> 16; }
typedef float f32x2_t __attribute__((ext_vector_type(2)));
typedef __bf16 bf16x2_t __attribute__((ext_vector_type(2)));
typedef short bf16x8 __attribute__((ext_vector_type(8)));
__device__ __forceinline__ unsigned pk2(float lo, float hi) { f32x2_t v = {lo, hi}; bf16x2_t r = __builtin_convertvector(v, bf16x2_t); return __builtin_bit_cast(unsigned, r); }
#define LBAR() do { asm volatile("s_waitcnt lgkmcnt(0)" ::: "memory"); __builtin_amdgcn_s_barrier(); asm volatile("" ::: "memory"); } while (0)
#define MFMA16(a, b, c) __builtin_amdgcn_mfma_f32_16x16x32_bf16((a), (b), (c), 0, 0, 0)
__device__ __forceinline__ float bflo(unsigned w) { return __uint_as_float(w << 16); }
__device__ __forceinline__ float bfhi(unsigned w) { return __uint_as_float(w & 0xffff0000u); }
__device__ __forceinline__ void unpack8(const u32x4 w, float (&f)[8]) {
    f[0] = bflo(w.x); f[1] = bfhi(w.x); f[2] = bflo(w.y); f[3] = bfhi(w.y); f[4] = bflo(w.z); f[5] = bfhi(w.z); f[6] = bflo(w.w); f[7] = bfhi(w.w);
}
__device__ __forceinline__ float wave_sum(float v) {
#pragma unroll
    for (int o = 1; o < 64; o <<= 1) v += __shfl_xor(v, o);
    return v;
}
__device__ __forceinline__ int batch_of_row(int row) { return row < TP ? (row >> 11) : 16 + ((row - TP) >> 12); }
__device__ __forceinline__ float silu(float g) { return g / (1.0f + __expf(-g)); }
__device__ __forceinline__ float sigm(float g) { return 1.0f / (1.0f + __expf(-g)); }

__device__ __forceinline__ void gemv24_item(const float* W, int N, int j0, LAS float* sc, LAS float* red, float (&res)[6], const int tid) {
    const int lane = tid & 63, wave = tid >> 6, cg = lane & 31, ks = wave * 2 + (lane >> 5);
    f32x4 acc[24];
#pragma unroll
    for (int b = 0; b < 24; ++b) acc[b] = (f32x4){0.f, 0.f, 0.f, 0.f};
    const float* w = W + (size_t)(ks * 64) * N + j0 + cg * 4;
#pragma unroll 8
    for (int kk = 0; kk < 64; ++kk) {
        const f32x4 wv = *(const f32x4*)(w + (size_t)kk * N);
        const LAS f32x4* s4 = (const LAS f32x4*)(sc + (ks * 64 + kk) * 24);
#pragma unroll
        for (int b4 = 0; b4 < 6; ++b4) { const f32x4 s = s4[b4]; acc[4 * b4] += wv * s[0]; acc[4 * b4 + 1] += wv * s[1]; acc[4 * b4 + 2] += wv * s[2]; acc[4 * b4 + 3] += wv * s[3]; }
    }
#pragma unroll
    for (int bg = 0; bg < 3; ++bg) {
#pragma unroll
        for (int bb = 0; bb < 8; ++bb) {
            f32x4 a = acc[8 * bg + bb];
            a[0] += __shfl_xor(a[0], 32); a[1] += __shfl_xor(a[1], 32); a[2] += __shfl_xor(a[2], 32); a[3] += __shfl_xor(a[3], 32);
            if (lane < 32) *(LAS f32x4*)(red + ((wave * 8 + bb) * 128 + cg * 4)) = a;
        }
        __syncthreads();
#pragma unroll
        for (int h = 0; h < 2; ++h) {
            const int bb = 4 * h + (tid >> 7), j = tid & 127;
            float s = 0.f;
#pragma unroll
            for (int wv = 0; wv < 8; ++wv) s += red[(wv * 8 + bb) * 128 + j];
            res[2 * bg + h] = s;
        }
        __syncthreads();
    }
}
__device__ __forceinline__ void phase_mod(const Params& p, LAS unsigned char* lds, const int tid) {
    LAS float* sc = (LAS float*)lds;
    LAS float* red = (LAS float*)(lds + 98304);
    float* mod = (float*)(p.ws + WS_MOD);
    for (int e = tid; e < 24 * 1024; e += 512) {
        const int b = e >> 10, k = e & 1023;
        const float c = b < 16 ? p.cp[b * 1024 + k] : p.cs[(b - 16) * 1024 + k];
        sc[k * 24 + b] = silu(c);
    }
    __syncthreads();
    for (int item = blockIdx.x; item < 288; item += gridDim.x) {
        const int l = item / 72, j0 = (item % 72) * 128;
        float res[6];
        gemv24_item(p.w_mod + (size_t)l * 1024 * 9216, 9216, j0, sc, red, res, tid);
#pragma unroll
        for (int i = 0; i < 6; ++i) { const int e = tid + 512 * i, b = e >> 7, j = e & 127; mod[((size_t)l * 24 + b) * 9216 + j0 + j] = res[i] + p.b_mod[l * 9216 + j0 + j]; }
    }
    __syncthreads();
}

__device__ __forceinline__ void phase_shw(const Params& p, LAS unsigned char* lds, const int tid) {
    LAS float* sc = (LAS float*)lds;
    LAS float* red = (LAS float*)(lds + 98304);
    const float* mod = (const float*)(p.ws + WS_MOD);
    float* shw = (float*)(p.ws + WS_SHW);
    int have = -1;
    for (int it = 0; it < 2 * ((480 + 2 * (int)gridDim.x - 1) / (2 * (int)gridDim.x)); ++it) {
        const int item = ((it >> 1) * (int)gridDim.x + (int)blockIdx.x) * 2 + (it & 1);
        if (item >= 480) continue;
        const int l = item / 120, r = item % 120;
        const int sub = r < 44 ? 0 : (r < 76 ? 1 : 2);
        const int mat = sub == 1 ? 2 : ((r < 22 || (r >= 76 && r < 98)) ? 0 : 1);
        const int blk = r < 22 ? r : (r < 44 ? r - 22 : (r < 76 ? r - 44 : (r < 98 ? r - 76 : r - 98)));
        const int ffn = sub == 2 ? 1 : 0;
        const int N = mat == 2 ? NPJ : FF;
        const size_t woff = mat == 2 ? (size_t)l * D * NPJ : (size_t)(l * 2 + ffn) * D * FF;
        const float* W = (mat == 2 ? p.w_in : (mat == 0 ? p.wg : p.wu)) + woff;
        const int j0 = blk * 128;
        const int d0 = mat == 2 ? j0 : (blk * 256 + (mat == 1 ? 128 : 0));
        if (have != l * 3 + sub) {
            __syncthreads();
            for (int e = tid; e < 24 * 1024; e += 512) {
                const int b = e >> 10, k = e & 1023;
                sc[k * 24 + b] = mod[((size_t)(l * 24 + b) * 9 + sub * 3) * D + k];
            }
            have = l * 3 + sub;
            __syncthreads();
        }
        float res[6];
        gemv24_item(W, N, j0, sc, red, res, tid);
#pragma unroll
        for (int i = 0; i < 6; ++i) { const int e = tid + 512 * i, b = e >> 7, j = e & 127; shw[((size_t)(l * 3 + sub) * 24 + b) * 5632 + d0 + j] = res[i]; }
    }
    __syncthreads();
}

template <int MODE>
__device__ __forceinline__ void transpose_item(const float* W, int K, int N, bf16* WT, LAS float* scr, int item, int lane) {
    const int nblk = N / 32, kb = item / nblk, nb = item % nblk, k0 = 64 * kb, n0 = 32 * nb;
    const int rbase = MODE == 0 ? n0 : ((n0 >> 7) * 256 + (n0 & 127) + (MODE == 2 ? 128 : 0));
    float wv_[32];
#pragma unroll
    for (int i = 0; i < 32; ++i) wv_[i] = W[(size_t)(k0 + 2 * i + (lane >> 5)) * N + n0 + (lane & 31)];
#pragma unroll
    for (int i = 0; i < 32; ++i) scr[(2 * i + (lane >> 5)) * 33 + (lane & 31)] = wv_[i];
    asm volatile("s_waitcnt lgkmcnt(0)" ::: "memory");
    const int c = lane & 7;
#pragma unroll
    for (int j = 0; j < 4; ++j) { const int n = (lane >> 3) + 8 * j; const LAS float* s = scr + (8 * c) * 33 + n;
        u32x4 o; o.x = pk2(s[0 * 33], s[1 * 33]); o.y = pk2(s[2 * 33], s[3 * 33]); o.z = pk2(s[4 * 33], s[5 * 33]); o.w = pk2(s[6 * 33], s[7 * 33]);
        *(u32x4*)(WT + (size_t)(rbase + n) * K + k0 + 8 * c) = o; }
    asm volatile("s_waitcnt lgkmcnt(0)" ::: "memory");
}
constexpr int I_G = 16 * 88, I_D = 44 * 32, I_IN = 16 * 128, I_OUT = 16 * 32;
constexpr int NW_A = 2 * I_G + I_D + I_IN, NW_B = I_OUT + 2 * I_G + I_D;
__device__ __forceinline__ void weights_item(const Params& p, int l, bool setB, int r, LAS float* scr, int lane) {
    const size_t fsz = (size_t)D * FF;
    if (!setB) {
        if (r < I_G) { transpose_item<1>(p.wg + (size_t)(l * 2 + 0) * fsz, D, FF, (bf16*)(p.ws + WS_WGU0), scr, r, lane); return; } r -= I_G;
        if (r < I_G) { transpose_item<2>(p.wu + (size_t)(l * 2 + 0) * fsz, D, FF, (bf16*)(p.ws + WS_WGU0), scr, r, lane); return; } r -= I_G;
        if (r < I_D) { transpose_item<0>(p.wd + (size_t)(l * 2 + 0) * fsz, FF, D, (bf16*)(p.ws + WS_WD0), scr, r, lane); return; } r -= I_D;
        transpose_item<0>(p.w_in + (size_t)l * D * NPJ, D, NPJ, (bf16*)(p.ws + WS_WIN), scr, r, lane);
    } else {
        if (r < I_OUT) { transpose_item<0>(p.w_out + (size_t)l * D * D, D, D, (bf16*)(p.ws + WS_WOUT), scr, r, lane); return; } r -= I_OUT;
        if (r < I_G) { transpose_item<1>(p.wg + (size_t)(l * 2 + 1) * fsz, D, FF, (bf16*)(p.ws + WS_WGU1), scr, r, lane); return; } r -= I_G;
        if (r < I_G) { transpose_item<2>(p.wu + (size_t)(l * 2 + 1) * fsz, D, FF, (bf16*)(p.ws + WS_WGU1), scr, r, lane); return; } r -= I_G;
        transpose_item<0>(p.wd + (size_t)(l * 2 + 1) * fsz, FF, D, (bf16*)(p.ws + WS_WD1), scr, r, lane);
    }
}
__device__ __forceinline__ void phase_weights_a0(const Params& p, LAS unsigned char* lds, const int tid) {
    const int wave = tid >> 6, lane = tid & 63;
    LAS float* scr = (LAS float*)(lds + wave * 16384);
    const int gw = blockIdx.x * 8 + wave, NGW = gridDim.x * 8;
    for (int it = gw; it < NW_A; it += NGW) weights_item(p, 0, false, it, scr, lane);
}

__device__ __forceinline__ void phase_norm_first(const Params& p, const int tid) {
    const int wave = tid >> 6, lane = tid & 63;
    const int gw = blockIdx.x * 8 + wave, NGW = gridDim.x * 8;
    const f32x4* g4 = (const f32x4*)(p.norm_g) + lane;
    const float* mod = (const float*)(p.ws + WS_MOD);
    bf16* H = (bf16*)(p.ws + WS_H);
    float* ssq = (float*)(p.ws + WS_SSQ);
    for (int row = gw; row < T; row += NGW) {
        const float* xr = row < TP ? p.xp + (size_t)row * D : p.xs + (size_t)(row - TP) * D;
        const int b = batch_of_row(row);
        const f32x4* sc4 = (const f32x4*)(mod + ((size_t)b * 9 + 1) * D) + lane;
        const f32x4* x4 = (const f32x4*)xr + lane;
        f32x4 v[4]; float s = 0.f;
#pragma unroll
        for (int j = 0; j < 4; ++j) { v[j] = x4[64 * j]; s += (v[j].x * v[j].x + v[j].y * v[j].y) + (v[j].z * v[j].z + v[j].w * v[j].w); }
        s = wave_sum(s);
        if (lane == 0) ssq[row] = s;
        u32x2* o8 = (u32x2*)(H + (size_t)row * D) + lane;
#pragma unroll
        for (int j = 0; j < 4; ++j) {
            const f32x4 y = v[j] * g4[64 * j] * (sc4[64 * j] + 1.0f);
            u32x2 w; w.x = pk2(y.x, y.y); w.y = pk2(y.z, y.w);
            o8[64 * j] = w;
        }
    }
}

constexpr int HB_QB = 0, HB_QM = 8704, HB_KM = 17408, HB_KLT = 26112, HB_VT = 36352, HB_AM = 46592, HB_DEC = 49152, HB_TOT = 49664, HB_SIZE = 51712;
__device__ __forceinline__ void hgrn_chain_ws(const Params& p, int l, int ch, LAS unsigned char* lds, const int tid) {
    const int seq = ch >> 3, head = (ch >> 1) & 3, dir = ch & 1;
    const int tb = seq < 16 ? seq * 2048 : TP + (seq - 16) * 4096, L = seq < 16 ? 2048 : 4096;
    bf16* proj = (bf16*)(p.ws + WS_BIG);
    const int cq = head * 128, cf = 512 + dir * 512 + head * 128, ci = 1536 + head * 128;
    const int lane = tid & 63, w = __builtin_amdgcn_readfirstlane(tid >> 6), r16 = lane & 15, g = lane >> 4;
    const int nch = L / 32;
    const char* pbase = (const char*)proj + (size_t)tb * (PJP * 2);
#define WS_CBASE(cn) (pbase + (size_t)(dir ? (L - 32 * ((cn) + 1)) : 32 * (cn)) * (PJP * 2))
    if (w < 4) {
        const int kp = tid & 63, tq = tid >> 6;
        float lb0, lb1;
        {
            const float* raw = (dir ? p.lbb : p.lbf) + head * 128 + 2 * kp;
            float lbv[2];
#pragma unroll
            for (int c2 = 0; c2 < 2; ++c2) {
                const float a0 = raw[c2], a1 = raw[512 + c2], a2 = raw[1024 + c2], a3 = raw[1536 + c2];
                const float mx = fmaxf(fmaxf(a0, a1), fmaxf(a2, a3));
                const float e0 = __expf(a0 - mx), e1 = __expf(a1 - mx), e2 = __expf(a2 - mx), e3 = __expf(a3 - mx);
                float num = 0.f; if (l >= 1) num += e1; if (l >= 2) num += e2; if (l >= 3) num += e3;
                lbv[c2] = num / ((e0 + e1) + (e2 + e3));
            }
            lb0 = lbv[0]; lb1 = lbv[1];
        }
        const float oml0 = 1.0f - lb0, oml1 = 1.0f - lb1;
        unsigned voffL[8];
#pragma unroll
        for (int e = 0; e < 8; ++e) { const int rl = dir ? (31 - 8 * tq - e) : (8 * tq + e); voffL[e] = (unsigned)(rl * (PJP * 2) + kp * 4); }
        unsigned rq[8], rf[8], ri[8];
        float q0[8], q1[8], kk0[8], kk1[8], bb0[8], bb1[8]; unsigned vr[8];
        typedef float f32x2v __attribute__((ext_vector_type(2)));
#define WS_LOAD(cn) do { const char* cb_ = WS_CBASE(cn); const char* bq_ = cb_ + cq * 2; const char* bf_ = cb_ + cf * 2; const char* bi_ = cb_ + ci * 2; \
        _Pragma("unroll") for (int e = 0; e < 8; ++e) { rq[e] = *(const unsigned*)(bq_ + voffL[e]); rf[e] = *(const unsigned*)(bf_ + voffL[e]); ri[e] = *(const unsigned*)(bi_ + voffL[e]); } } while (0)
#define WS_P1(cn) do { LAS float* TOT_ = (LAS float*)(lds + ((cn) & 1) * HB_SIZE + HB_TOT); float run0_ = 0.f, run1_ = 0.f; \
        _Pragma("unroll") for (int e = 0; e < 8; ++e) { q0[e] = bflo(rq[e]); q1[e] = bfhi(rq[e]); vr[e] = ri[e]; \
            const float f0_ = lb0 + oml0 * bflo(rf[e]), f1_ = lb1 + oml1 * bfhi(rf[e]); \
            run0_ += fmaxf(__log2f(f0_), -7.9f); run1_ += fmaxf(__log2f(f1_), -7.9f);        \
            bb0[e] = run0_; bb1[e] = run1_; kk0[e] = 1.0f - f0_; kk1[e] = 1.0f - f1_; } \
        *(LAS f32x2v*)(TOT_ + tq * 128 + 2 * kp) = (f32x2v){run0_, run1_}; } while (0)
#define WS_P2(cn) do { LAS unsigned char* B_ = lds + ((cn) & 1) * HB_SIZE; \
        LAS bf16* QM_ = (LAS bf16*)(B_ + HB_QM); LAS bf16* KM_ = (LAS bf16*)(B_ + HB_KM); \
        LAS bf16* KLT_ = (LAS bf16*)(B_ + HB_KLT); LAS bf16* VT_ = (LAS bf16*)(B_ + HB_VT); LAS float* DEC_ = (LAS float*)(B_ + HB_DEC); LAS float* TOT_ = (LAS float*)(B_ + HB_TOT); \
        const f32x2v t0 = *(const LAS f32x2v*)(TOT_ + 2 * kp), t1 = *(const LAS f32x2v*)(TOT_ + 128 + 2 * kp), t2 = *(const LAS f32x2v*)(TOT_ + 256 + 2 * kp), t3 = *(const LAS f32x2v*)(TOT_ + 384 + 2 * kp); \
        const f32x2v z2 = (f32x2v){0.f, 0.f}; \
        const f32x2v off = tq == 0 ? z2 : (tq == 1 ? t0 : (tq == 2 ? t0 + t1 : (t0 + t1) + t2)); \
        const f32x2v bm = t0 + t1, b31 = (t0 + t1) + (t2 + t3);            \
        const float sbm0 = __builtin_amdgcn_exp2f(bm.x), sbm1 = __builtin_amdgcn_exp2f(bm.y), s310 = __builtin_amdgcn_exp2f(b31.x - bm.x), s311 = __builtin_amdgcn_exp2f(b31.y - bm.y); \
        float kl0[8], kl1[8]; \
        _Pragma("unroll") for (int e = 0; e < 8; ++e) { const int i = 8 * tq + e; \
            const float d0_ = off.x + bb0[e] - bm.x, d1_ = off.y + bb1[e] - bm.y; \
            const float qm0 = q0[e] * __builtin_amdgcn_exp2f(d0_), qm1 = q1[e] * __builtin_amdgcn_exp2f(d1_); \
            const float km0 = kk0[e] * __builtin_amdgcn_exp2f(-d0_), km1 = kk1[e] * __builtin_amdgcn_exp2f(-d1_); \
            *(LAS unsigned*)(QM_ + i * 136 + 2 * kp) = pk2(qm0, qm1); *(LAS unsigned*)(KM_ + i * 136 + 2 * kp) = pk2(km0, km1); \
            kl0[e] = km0 * s310; kl1[e] = km1 * s311; } \
        u32x4 wk0, wk1, wv0, wv1; \
        wk0.x = pk2(kl0[0], kl0[1]); wk0.y = pk2(kl0[2], kl0[3]); wk0.z = pk2(kl0[4], kl0[5]); wk0.w = pk2(kl0[6], kl0[7]); \
        wk1.x = pk2(kl1[0], kl1[1]); wk1.y = pk2(kl1[2], kl1[3]); wk1.z = pk2(kl1[4], kl1[5]); wk1.w = pk2(kl1[6], kl1[7]); \
        wv0.x = (vr[0] & 0xffffu) | (vr[1] << 16); wv0.y = (vr[2] & 0xffffu) | (vr[3] << 16); wv0.z = (vr[4] & 0xffffu) | (vr[5] << 16); wv0.w = (vr[6] & 0xffffu) | (vr[7] << 16); \
        wv1.x = (vr[0] >> 16) | (vr[1] & 0xffff0000u); wv1.y = (vr[2] >> 16) | (vr[3] & 0xffff0000u); wv1.z = (vr[4] >> 16) | (vr[5] & 0xffff0000u); wv1.w = (vr[6] >> 16) | (vr[7] & 0xffff0000u); \
        *(LAS u32x4*)(KLT_ + (2 * kp) * 40 + 8 * tq) = wk0; *(LAS u32x4*)(KLT_ + (2 * kp + 1) * 40 + 8 * tq) = wk1; \
        *(LAS u32x4*)(VT_ + (2 * kp) * 40 + 8 * tq) = wv0; *(LAS u32x4*)(VT_ + (2 * kp + 1) * 40 + 8 * tq) = wv1; \
        if (tq == 0) { *(LAS f32x2v*)(DEC_ + 2 * kp) = (f32x2v){__builtin_amdgcn_exp2f(b31.x), __builtin_amdgcn_exp2f(b31.y)}; *(LAS f32x2v*)((LAS float*)(B_ + HB_QB) + 2 * kp) = (f32x2v){sbm0, sbm1}; } } while (0)
        WS_LOAD(0);
        WS_P1(0);
        LBAR();
        WS_P2(0);
        WS_LOAD(1);
        WS_P1(1);
        LBAR();
        for (int c = 0; c < nch; ++c) {
            WS_LOAD(min(c + 2, nch - 1));
            WS_P2(c + 1);
            LBAR();
            WS_P1(c + 2);
            LBAR();
        }
#undef WS_LOAD
#undef WS_P1
#undef WS_P2
    } else {
        const int mw = w - 4;
        f32x4 S[8][2];
#pragma unroll
        for (int t = 0; t < 8; ++t) { S[t][0] = (f32x4){0.f, 0.f, 0.f, 0.f}; S[t][1] = S[t][0]; }
        unsigned voffS[2][8];
#pragma unroll
        for (int vt = 0; vt < 2; ++vt)
#pragma unroll
            for (int e = 0; e < 8; ++e) { const int ps = 16 * (e >> 2) + 4 * g + (e & 3), rs_ = dir ? (31 - ps) : ps; voffS[vt][e] = (unsigned)(rs_ * (PJP * 2) + (16 * (2 * mw + vt) + r16) * 2); }
        const int sti = (mw == 1 || mw == 2) ? 1 : 0, stj = (mw >= 2) ? 1 : 0;
        LBAR();
        LBAR();
        for (int c = 0; c < nch; ++c) {
            LAS unsigned char* B = lds + (c & 1) * HB_SIZE;
            LAS bf16* QB = (LAS bf16*)(B + HB_QB); LAS bf16* QM = (LAS bf16*)(B + HB_QM); LAS bf16* KM = (LAS bf16*)(B + HB_KM);
            LAS bf16* KLT = (LAS bf16*)(B + HB_KLT); LAS bf16* VT = (LAS bf16*)(B + HB_VT); LAS bf16* AM = (LAS bf16*)(B + HB_AM);
            LAS float* DEC = (LAS float*)(B + HB_DEC); LAS float* SBM = (LAS float*)(B + HB_QB);
            {
                f32x4 sc = (f32x4){0.f, 0.f, 0.f, 0.f};
#pragma unroll
                for (int s = 0; s < 4; ++s) {
                    const bf16x8 a = *(const LAS bf16x8*)(QM + (16 * sti + r16) * 136 + 32 * s + 8 * g);
                    const bf16x8 b = *(const LAS bf16x8*)(KM + (16 * stj + r16) * 136 + 32 * s + 8 * g);
                    sc = MFMA16(a, b, sc);
                }
#pragma unroll
                for (int r = 0; r < 4; ++r) {
                    const int i = 16 * sti + 4 * g + r, j = 16 * stj + r16;
                    const float val = (j <= i) ? sc[r] : 0.f;
                    AM[i * 40 + j] = (bf16)(pk2(val, 0.f) & 0xffffu);
                }
            }
            f32x4 O[2][2];
#pragma unroll
            for (int ti = 0; ti < 2; ++ti) { O[ti][0] = (f32x4){0.f, 0.f, 0.f, 0.f}; O[ti][1] = O[ti][0]; }
#pragma unroll
            for (int s = 0; s < 4; ++s) {
                bf16x8 bfrag[2];
                const f32x4 m0 = *(const LAS f32x4*)(SBM + 32 * s + 4 * g), m1 = *(const LAS f32x4*)(SBM + 32 * s + 16 + 4 * g);
#pragma unroll
                for (int vt = 0; vt < 2; ++vt) {
                    const f32x4 s0 = S[2 * s][vt] * m0, s1 = S[2 * s + 1][vt] * m1;
                    u32x4 bw; bw.x = pk2(s0[0], s0[1]); bw.y = pk2(s0[2], s0[3]); bw.z = pk2(s1[0], s1[1]); bw.w = pk2(s1[2], s1[3]);
                    bfrag[vt] = __builtin_bit_cast(bf16x8, bw);
                }
#pragma unroll
                for (int ti = 0; ti < 2; ++ti) {
                    const u32x2 lo = *(const LAS u32x2*)(QM + (16 * ti + r16) * 136 + 32 * s + 4 * g);
                    const u32x2 hi = *(const LAS u32x2*)(QM + (16 * ti + r16) * 136 + 32 * s + 16 + 4 * g);
                    u32x4 aw; aw.x = lo.x; aw.y = lo.y; aw.z = hi.x; aw.w = hi.y;
                    const bf16x8 af = __builtin_bit_cast(bf16x8, aw);
                    O[ti][0] = MFMA16(af, bfrag[0], O[ti][0]);
                    O[ti][1] = MFMA16(af, bfrag[1], O[ti][1]);
                }
            }
            bf16x8 vfrag[2];
#pragma unroll
            for (int vt = 0; vt < 2; ++vt) vfrag[vt] = *(const LAS bf16x8*)(VT + (16 * (2 * mw + vt) + r16) * 40 + 8 * g);
#pragma unroll
            for (int t = 0; t < 8; ++t) {
                const f32x4 d4 = *(const LAS f32x4*)(DEC + 16 * t + 4 * g);
                const bf16x8 a = *(const LAS bf16x8*)(KLT + (16 * t + r16) * 40 + 8 * g);
                S[t][0] = MFMA16(a, vfrag[0], S[t][0] * d4);
                S[t][1] = MFMA16(a, vfrag[1], S[t][1] * d4);
            }
            LBAR();
#pragma unroll
            for (int ti = 0; ti < 2; ++ti) {
                const bf16x8 a = *(const LAS bf16x8*)(AM + (16 * ti + r16) * 40 + 8 * g);
                O[ti][0] = MFMA16(a, vfrag[0], O[ti][0]);
                O[ti][1] = MFMA16(a, vfrag[1], O[ti][1]);
            }
            {
                char* sb_ = (char*)WS_CBASE(c) + cf * 2;
#pragma unroll
                for (int vt = 0; vt < 2; ++vt)
#pragma unroll
                    for (int ti = 0; ti < 2; ++ti)
#pragma unroll
                        for (int r = 0; r < 4; ++r) *(unsigned short*)(sb_ + voffS[vt][ti * 4 + r]) = (unsigned short)(pk2(O[ti][vt][r], 0.f) & 0xffffu);
            }
            LBAR();
        }
    }
#undef WS_CBASE
    __syncthreads();
}

constexpr int NA_KS = 0, NA_VT = 73728, NA_RK = 140288, NA_RPB = 142336, NA_END = 144256, NA_XCH = NA_END + 1024;
__device__ __forceinline__ void na_stage_store(const u32x4 kw, const u32x4 vw, int kr, LAS unsigned char* lds, const int tid) {
    const int key = tid >> 3, ch = tid & 7, slot = kr & 7;
    float f[8]; unpack8(kw, f);
    float ss = 0.f;
#pragma unroll
    for (int e = 0; e < 8; ++e) ss += f[e] * f[e];
    ss += __shfl_xor(ss, 1); ss += __shfl_xor(ss, 2); ss += __shfl_xor(ss, 4);
    *(LAS u32x4*)((LAS bf16*)(lds + NA_KS) + (slot * 64 + key) * 72 + ch * 8) = kw;
    if (ch == 0) ((LAS float*)(lds + NA_RK))[slot * 64 + key] = __builtin_amdgcn_rsqf(ss * (1.f / 64.f) + EPS);
    LAS bf16* vt = (LAS bf16*)(lds + NA_VT) + (ch * 8) * 520 + slot * 64 + key;
    vt[0 * 520] = (bf16)(vw.x & 0xffffu); vt[1 * 520] = (bf16)(vw.x >> 16); vt[2 * 520] = (bf16)(vw.y & 0xffffu); vt[3 * 520] = (bf16)(vw.y >> 16);
    vt[4 * 520] = (bf16)(vw.z & 0xffffu); vt[5 * 520] = (bf16)(vw.z >> 16); vt[6 * 520] = (bf16)(vw.w & 0xffffu); vt[7 * 520] = (bf16)(vw.w >> 16);
}
__device__ __forceinline__ void na_unit_mfma(const Params& p, int l, int unit, LAS unsigned char* lds, const int tid) {
    int seq, h, run, rows, seqbase;
    if (unit < 512) { seq = unit >> 5; h = (unit >> 2) & 7; run = unit & 3; rows = 32; seqbase = seq * 2048; }
    else { const int u2 = unit - 512; seq = u2 >> 6; h = (u2 >> 3) & 7; run = u2 & 7; rows = 64; seqbase = TP + seq * 4096; }
    const bf16* proj = (const bf16*)(p.ws + WS_BIG);
    bf16* mix = (bf16*)(p.ws + WS_H);
    const int lane = tid & 63, w = __builtin_amdgcn_readfirstlane(tid >> 6), r16 = lane & 15, g = lane >> 4;
    const int jq = w & 3, hh = w >> 2;
    const int qc = 16 * jq + r16;
    const int kc0 = min(max(16 * jq - 8, 0), 32);
    const int c0 = min(max(qc - 8, 0), 48);
    LAS float* RPB = (LAS float*)(lds + NA_RPB);
    LAS float* RK = (LAS float*)(lds + NA_RK);
    LAS bf16* KS = (LAS bf16*)(lds + NA_KS);
    LAS bf16* VTS = (LAS bf16*)(lds + NA_VT);
    __syncthreads();
    if (tid < 465) RPB[tid] = p.rpb[(size_t)(l * 8 + h) * 465 + tid];
    LAS float* GQK = (LAS float*)(lds + NA_END + 256);
    if (tid < 64) GQK[tid] = p.qng[l * 64 + tid] * p.kng[l * 64 + tid];
    int bidx[8]; unsigned vmask = 0u;
#pragma unroll
    for (int ce = 0; ce < 8; ++ce) {
        const int kc = kc0 + 16 * (ce >> 2) + 4 * g + (ce & 3);
        bidx[ce] = min(max(kc, qc - 15), qc + 15);
        if (kc >= c0 && kc < c0 + 16) vmask |= 1u << ce;
    }
    const bf16* src0 = proj + (size_t)(seqbase + (tid >> 3)) * PJP + 3072 + h * 64 + (tid & 7) * 8;
    const bf16* qsrc0 = proj + (size_t)(seqbase + qc) * PJP + 2560 + h * 64 + 8 * g;
    int staged_hi;
    u32x4 qa, qb, nkw, nvw;
    {
        const int r = run * 8, r0 = min(max(r - 4, 0), rows - 8);
        u32x4 kw[8], vw[8];
#pragma unroll
        for (int i = 0; i < 8; ++i) { const bf16* s_ = src0 + (size_t)(r0 + i) * 64 * PJP; kw[i] = *(const u32x4*)s_; vw[i] = *(const u32x4*)(s_ + 512); }
        qa = *(const u32x4*)(qsrc0 + (size_t)r * 64 * PJP); qb = *(const u32x4*)(qsrc0 + (size_t)r * 64 * PJP + 32);
        __syncthreads();
#pragma unroll
        for (int i = 0; i < 8; ++i) na_stage_store(kw[i], vw[i], r0 + i, lds, tid);
        staged_hi = r0 + 7;
        nkw = kw[0]; nvw = vw[0];
    }
    for (int rq = 0; rq < 8; ++rq) {
        const int r = run * 8 + rq;
        const int r0 = min(max(r - 4, 0), rows - 8);
        LBAR();
        if (r0 + 7 > staged_hi) { na_stage_store(nkw, nvw, r0 + 7, lds, tid); staged_hi = r0 + 7; }
        const int tokq = seqbase + r * 64 + qc;
        bf16x8 qfrag[2];
        {
            float q0[8], q1[8]; unpack8(qa, q0); unpack8(qb, q1);
            float ss = 0.f;
#pragma unroll
            for (int e = 0; e < 8; ++e) ss += q0[e] * q0[e] + q1[e] * q1[e];
            ss += __shfl_xor(ss, 16); ss += __shfl_xor(ss, 32);
            const float rs = 0.125f * __builtin_amdgcn_rsqf(ss * (1.f / 64.f) + EPS);
            float gqk[2][8];
#pragma unroll
            for (int s = 0; s < 2; ++s) { const f32x4 ga = *(const LAS f32x4*)(GQK + 32 * s + 8 * g), gb = *(const LAS f32x4*)(GQK + 32 * s + 8 * g + 4);
                gqk[s][0] = ga[0]; gqk[s][1] = ga[1]; gqk[s][2] = ga[2]; gqk[s][3] = ga[3]; gqk[s][4] = gb[0]; gqk[s][5] = gb[1]; gqk[s][6] = gb[2]; gqk[s][7] = gb[3]; }
            u32x4 a, b;
            a.x = pk2(q0[0] * rs * gqk[0][0], q0[1] * rs * gqk[0][1]); a.y = pk2(q0[2] * rs * gqk[0][2], q0[3] * rs * gqk[0][3]);
            a.z = pk2(q0[4] * rs * gqk[0][4], q0[5] * rs * gqk[0][5]); a.w = pk2(q0[6] * rs * gqk[0][6], q0[7] * rs * gqk[0][7]);
            b.x = pk2(q1[0] * rs * gqk[1][0], q1[1] * rs * gqk[1][1]); b.y = pk2(q1[2] * rs * gqk[1][2], q1[3] * rs * gqk[1][3]);
            b.z = pk2(q1[4] * rs * gqk[1][4], q1[5] * rs * gqk[1][5]); b.w = pk2(q1[6] * rs * gqk[1][6], q1[7] * rs * gqk[1][7]);
            qfrag[0] = __builtin_bit_cast(bf16x8, a); qfrag[1] = __builtin_bit_cast(bf16x8, b);
        }
        LBAR();
        if (rq < 7) {
            const int rn = r + 1, r0n = min(max(rn - 4, 0), rows - 8);
            qa = *(const u32x4*)(qsrc0 + (size_t)rn * 64 * PJP); qb = *(const u32x4*)(qsrc0 + (size_t)rn * 64 * PJP + 32);
            if (r0n + 7 > staged_hi) { const bf16* s_ = src0 + (size_t)(r0n + 7) * 64 * PJP; nkw = *(const u32x4*)s_; nvw = *(const u32x4*)(s_ + 512); }
        }
        f32x4 sc[8];
        float m = -3.0e38f;
#pragma unroll
        for (int r4 = 0; r4 < 4; ++r4) {
            const int rr = 4 * hh + r4;
            const int slot = (r0 + rr) & 7;
            const LAS float* brow = RPB + (r0 + rr - r + 7) * 31 + 15 - qc;
            float bias[8];
#pragma unroll
            for (int ce = 0; ce < 8; ++ce) bias[ce] = brow[bidx[ce]];
#pragma unroll
            for (int ct = 0; ct < 2; ++ct) {
                f32x4 acc = (f32x4){0.f, 0.f, 0.f, 0.f};
                const LAS bf16* kp = KS + (slot * 64 + kc0 + 16 * ct + r16) * 72 + 8 * g;
                acc = MFMA16(*(const LAS bf16x8*)kp, qfrag[0], acc);
                acc = MFMA16(*(const LAS bf16x8*)(kp + 32), qfrag[1], acc);
                const f32x4 rk4 = *(const LAS f32x4*)(RK + slot * 64 + kc0 + 16 * ct + 4 * g);
#pragma unroll
                for (int e = 0; e < 4; ++e) {
                    const float v0 = acc[e] * rk4[e] + bias[ct * 4 + e];
                    const float v = ((vmask >> (ct * 4 + e)) & 1u) ? v0 : -3.0e38f;
                    acc[e] = v; m = fmaxf(m, v);
                }
                sc[r4 * 2 + ct] = acc;
            }
        }
        m = fmaxf(m, __shfl_xor(m, 16)); m = fmaxf(m, __shfl_xor(m, 32));
        float lsum = 0.f;
#pragma unroll
        for (int t = 0; t < 8; ++t)
#pragma unroll
            for (int e = 0; e < 4; ++e) { const float pv = __expf(sc[t][e] - m); sc[t][e] = pv; lsum += pv; }
        lsum += __shfl_xor(lsum, 16); lsum += __shfl_xor(lsum, 32);
        f32x4 O[4];
#pragma unroll
        for (int dt = 0; dt < 4; ++dt) O[dt] = (f32x4){0.f, 0.f, 0.f, 0.f};
#pragma unroll
        for (int r4 = 0; r4 < 4; ++r4) {
            const int slot = (r0 + 4 * hh + r4) & 7;
            u32x4 bw; bw.x = pk2(sc[2 * r4][0], sc[2 * r4][1]); bw.y = pk2(sc[2 * r4][2], sc[2 * r4][3]); bw.z = pk2(sc[2 * r4 + 1][0], sc[2 * r4 + 1][1]); bw.w = pk2(sc[2 * r4 + 1][2], sc[2 * r4 + 1][3]);
            const bf16x8 bfrag = __builtin_bit_cast(bf16x8, bw);
#pragma unroll
            for (int dt = 0; dt < 4; ++dt) {
                const LAS bf16* vp = VTS + (16 * dt + r16) * 520 + slot * 64 + kc0 + 4 * g;
                const u32x2 lo = *(const LAS u32x2*)vp, hi = *(const LAS u32x2*)(vp + 16);
                u32x4 aw; aw.x = lo.x; aw.y = lo.y; aw.z = hi.x; aw.w = hi.y;
                O[dt] = MFMA16(__builtin_bit_cast(bf16x8, aw), bfrag, O[dt]);
            }
        }
        LAS unsigned* X = (LAS unsigned*)(lds + NA_XCH) + jq * 64 + lane;
        if (hh == 1) {
            X[0 * 256] = __float_as_uint(m); X[1 * 256] = __float_as_uint(lsum);
#pragma unroll
            for (int dt = 0; dt < 4; ++dt) { X[(2 + 2 * dt) * 256] = pk2(O[dt][0], O[dt][1]); X[(3 + 2 * dt) * 256] = pk2(O[dt][2], O[dt][3]); }
        }
        LBAR();
        if (hh == 0) {
            const float m1 = __uint_as_float(X[0 * 256]), l1 = __uint_as_float(X[1 * 256]);
            const float mm = fmaxf(m, m1), a0 = __expf(m - mm), a1 = __expf(m1 - mm);
            const float inv = __builtin_amdgcn_rcpf(lsum * a0 + l1 * a1);
            const float c0_ = a0 * inv, c1_ = a1 * inv;
#pragma unroll
            for (int dt = 0; dt < 4; ++dt) {
                const unsigned w0 = X[(2 + 2 * dt) * 256], w1 = X[(3 + 2 * dt) * 256];
                u32x2 ow;
                ow.x = pk2(O[dt][0] * c0_ + bflo(w0) * c1_, O[dt][1] * c0_ + bfhi(w0) * c1_);
                ow.y = pk2(O[dt][2] * c0_ + bflo(w1) * c1_, O[dt][3] * c0_ + bfhi(w1) * c1_);
                *(u32x2*)(mix + (size_t)tokq * D + 512 + h * 64 + 16 * dt + 4 * g) = ow;
            }
        }
    }
}

__device__ __forceinline__ void phase_mixer(const Params& p, int l, LAS unsigned char* lds, const int tid) {
    if (blockIdx.x < 192) hgrn_chain_ws(p, l, blockIdx.x, lds, tid);
    unsigned* ctr = (unsigned*)(p.ws + WS_CTL) + 64 * (l + 1);
    LAS unsigned* sh = (LAS unsigned*)(lds + NA_END);
    const int nwi = NW_B + (l + 1 < DEPTH ? NW_A : 0);
    const unsigned nunits = 1024u + (unsigned)((nwi + 7) / 8);
    for (;;) {
        if (tid == 0) sh[0] = atomicAdd(ctr, 1u);
        __syncthreads();
        const unsigned u = sh[0];
        __syncthreads();
        if (u >= nunits) break;
        if (u < 1024u) na_unit_mfma(p, l, (int)u, lds, tid);
        else {
            const int wave = tid >> 6, lane = tid & 63;
            const int item = (int)(u - 1024u) * 8 + wave;
            LAS float* scr = (LAS float*)(lds + wave * 16384);
            if (item < NW_B) weights_item(p, l, true, item, scr, lane);
            else if (item < nwi) weights_item(p, l + 1, false, item - NW_B, scr, lane);
        }
    }
}

__device__ __forceinline__ void phase_combine(const Params& p, int l, const int tid) {
    const int wave = tid >> 6, lane = tid & 63;
    const int gw = blockIdx.x * 8 + wave, NGW = gridDim.x * 8;
    const bf16* proj = (const bf16*)(p.ws + WS_BIG);
    bf16* mix = (bf16*)(p.ws + WS_H);
    const int col = (lane >> 4) * 128 + (lane & 15) * 8;
    float g[8];
#pragma unroll
    for (int j = 0; j < 8; ++j) g[j] = p.hgn[l * 128 + (lane & 15) * 8 + j];
    for (int tok = gw; tok < T; tok += NGW) {
        const bf16* row = proj + (size_t)tok * PJP;
        float a[8], b[8], hg[8];
        unpack8(*(const u32x4*)(row + 512 + col), a); unpack8(*(const u32x4*)(row + 1024 + col), b); unpack8(*(const u32x4*)(row + 2048 + col), hg);
        float ss = 0.f;
#pragma unroll
        for (int j = 0; j < 8; ++j) { a[j] += b[j]; ss += a[j] * a[j]; }
        ss += __shfl_xor(ss, 1); ss += __shfl_xor(ss, 2); ss += __shfl_xor(ss, 4); ss += __shfl_xor(ss, 8);
        const float rstd = 1.0f / sqrtf(ss * (1.f / 128.f) + EPS);
        float y[8];
#pragma unroll
        for (int j = 0; j < 8; ++j) y[j] = a[j] * rstd * g[j] * hg[j];
        u32x4 w; w.x = pk2(y[0], y[1]); w.y = pk2(y[2], y[3]); w.z = pk2(y[4], y[5]); w.w = pk2(y[6], y[7]);
        *(u32x4*)(mix + (size_t)tok * D + col) = w;
    }
}

#define RLX_AGENT __ATOMIC_RELAXED, __HIP_MEMORY_SCOPE_AGENT
constexpr int CW_BAR = 4096;
#define XB_TMO      128
#define XB_XCNT(j)  (256  + 64 * (j))
#define XB_XSUB(j)  (1280 + 64 * (j))
#define XB_XGEN(j)  (2304 + 64 * (j))
#define XB_TOP      3328
#define XB_TOPGEN   3392
#define XCD_BAR_WORDS 3456
#define XB_SPIN_CAP (1u << 18)

__device__ __forceinline__ unsigned xb_ld(unsigned* p)              { return __hip_atomic_load(p, __ATOMIC_RELAXED, __HIP_MEMORY_SCOPE_AGENT); }
__device__ __forceinline__ unsigned xb_add(unsigned* p, unsigned v) { return __hip_atomic_fetch_add(p, v, __ATOMIC_RELAXED, __HIP_MEMORY_SCOPE_AGENT); }
__device__ __forceinline__ unsigned xb_xcc_id() { return (unsigned)__builtin_amdgcn_s_getreg((3 << 11) | 20) & 0xFu; }
#define XB_SPIN(cond, bar) do { unsigned _sp = 0; while (cond) { __builtin_amdgcn_s_sleep(1); \
    if ((++_sp & 255u) == 0u) { if (xb_ld(&(bar)[XB_TMO])) break; if (_sp > XB_SPIN_CAP) { atomicAdd(&(bar)[XB_TMO], 1u); break; } } } } while (0)

struct XcdBarrier {
    unsigned* bar; unsigned x;
    volatile LAS unsigned* st;
};

__device__ __forceinline__ XcdBarrier xcd_barrier_post(unsigned* bar, volatile LAS unsigned* st) {
    XcdBarrier b; b.bar = bar; b.x = xb_xcc_id(); b.st = st;
    if (threadIdx.x == 0) (void)xb_add(&bar[XB_XCNT(b.x)], 1u);
    return b;
}
__device__ __forceinline__ void xcd_barrier_complete(unsigned* bar, unsigned x, unsigned& nloc, unsigned& nx) {
    const unsigned G = gridDim.x * gridDim.y * gridDim.z;
    unsigned sum, cnt, mine, sp = 0u;
    for (;;) {
        sum = 0u; cnt = 0u; mine = 0u;
#pragma unroll
        for (unsigned j = 0; j < 16; ++j) { const unsigned c = xb_ld(&bar[XB_XCNT(j)]); sum += c; cnt += (c > 0u) ? 1u : 0u; mine = (j == x) ? c : mine; }
        if (sum == G) break;
        __builtin_amdgcn_s_sleep(1);
        if ((++sp & 255u) == 0u) { if (xb_ld(&bar[XB_TMO])) break; if (sp > XB_SPIN_CAP) { atomicAdd(&bar[XB_TMO], 1u); break; } }
    }
    nloc = mine > 0u ? mine : 1u; nx = cnt > 0u ? cnt : 1u;
}

__device__ __forceinline__ void xcd_barrier(const XcdBarrier& b) {
    asm volatile("s_waitcnt vmcnt(0)" ::: "memory");
    __syncthreads();
    if (threadIdx.x == 0) {
        unsigned* bar = b.bar;
        __builtin_amdgcn_s_waitcnt(0);
        unsigned nloc = b.st[0], nx = b.st[1];
        if (nloc == 0u) { xcd_barrier_complete(bar, b.x, nloc, nx); b.st[0] = nloc; b.st[1] = nx; }
        const unsigned old = xb_add(&bar[XB_XSUB(b.x)], 1u);
        const unsigned gen = old / nloc;
        if (old + 1u == (gen + 1u) * nloc) {
            __builtin_amdgcn_fence(__ATOMIC_RELEASE, "agent");
            asm volatile("s_waitcnt vmcnt(0)" ::: "memory");
            const unsigned og = xb_add(&bar[XB_TOP], 1u);
            const unsigned tg = og / nx;
            if (og + 1u == (tg + 1u) * nx) xb_add(&bar[XB_TOPGEN], 1u);
            else XB_SPIN(xb_ld(&bar[XB_TOPGEN]) == tg, bar);
            __builtin_amdgcn_fence(__ATOMIC_ACQUIRE, "agent");
            xb_add(&bar[XB_XGEN(b.x)], 1u);
            asm volatile("s_waitcnt vmcnt(0)" ::: "memory");
        } else {
            XB_SPIN(xb_ld(&bar[XB_XGEN(b.x)]) == gen, bar);
            __builtin_amdgcn_fence(__ATOMIC_ACQUIRE, "agent");
            asm volatile("s_waitcnt vmcnt(0)" ::: "memory");
        }
    }
    __syncthreads();
}

template <class Epi>
__device__ __forceinline__ void run_gemm(LAS unsigned char* lds, const bf16* A, const bf16* Bt, int N, int K, const Epi& E, const int tid) {
    pg8::Gemm g{A, Bt, T, N, K}; pg8::StaticOrder S; S.init(T, N, (int)gridDim.x, (int)blockIdx.x);
    pg8::gemm_phase<Epi, pg8::StaticOrder, true, true>(lds, g, S, E, tid);
}

__global__ void __launch_bounds__(512, 2) fwd_kernel(Params p) {
    extern __shared__ __attribute__((aligned(16))) unsigned char lds_raw[];
    LAS unsigned char* lds = (LAS unsigned char*)lds_raw;
    volatile LAS unsigned* bst = (volatile LAS unsigned*)(lds + NA_END + 64);
    if (threadIdx.x < 4) bst[threadIdx.x] = 0u;
    __syncthreads();
    XcdBarrier bar = xcd_barrier_post((unsigned*)(p.ws + WS_CTL) + CW_BAR, bst);
    for (int ph = p.ph_lo; ph < p.ph_hi; ++ph) {
        if (ph > p.ph_lo) { if (ph == p.ph_lo + 1) cg::this_grid().sync(); else xcd_barrier(bar); }
        int tid = threadIdx.x; asm volatile("" : "+v"(tid));
        if (ph == 0) {
            for (int e = blockIdx.x * 512 + tid; e < 12 * D; e += gridDim.x * 512) ((float*)(p.ws + WS_NG))[e] = p.norm_g[e];
            phase_mod(p, lds, tid); continue; }
        const int l = ph < 2 ? 0 : (ph - 2) / 8, s = ph < 2 ? 0 : (ph - 2) % 8 + 1;
        float* ssq_all = (float*)(p.ws + WS_SSQ);
        const float* shw_all = (const float*)(p.ws + WS_SHW);
        if (s == 0) {
            phase_shw(p, lds, tid); asm volatile("" : "+v"(tid)); phase_weights_a0(p, lds, tid); asm volatile("" : "+v"(tid)); phase_norm_first(p, tid);
        }
        else if (s == 4) phase_mixer(p, l, lds, tid);
        else if (s == 5) phase_combine(p, l, tid);
        else if (s == 1 || s == 7) {
            const int sub = s == 1 ? 0 : 2;
            pg8::EpiSwiGLU E{(bf16*)(p.ws + WS_BIG), ssq_all + (size_t)(l * 3 + sub) * T, shw_all + (size_t)(l * 3 + sub) * 24 * 5632};
            run_gemm(lds, (const bf16*)(p.ws + (s == 1 ? WS_H : WS_H2)), (const bf16*)(p.ws + (s == 1 ? WS_WGU0 : WS_WGU1)), 2 * FF, D, E, tid);
        } else if (s == 3) {
            pg8::EpiProj E{(bf16*)(p.ws + WS_BIG), ssq_all + (size_t)(l * 3 + 1) * T, shw_all + (size_t)(l * 3 + 1) * 24 * 5632};
            run_gemm(lds, (const bf16*)(p.ws + WS_H), (const bf16*)(p.ws + WS_WIN), NPJ, D, E, tid);
        } else {
            const int sub = s == 2 ? 0 : (s == 6 ? 1 : 2);
            pg8::EpiRes E{p.xp, p.xs, p.out, p.ws, l, sub, ((l == 0) && s == 2) ? 1 : 0};
            const bf16* A = (const bf16*)(p.ws + (s == 6 ? WS_H : WS_BIG));
            const bf16* Bt = (const bf16*)(p.ws + (s == 2 ? WS_WD0 : (s == 6 ? WS_WOUT : WS_WD1)));
            run_gemm(lds, A, Bt, D, s == 6 ? D : FF, E, tid);
        }
    }
}

#ifndef N_LAUNCH_MODE
#define N_LAUNCH_MODE 1
#endif

extern "C" void kernel_launch(void* const* d_in, const int* in_sizes, int n_in, void* d_out, int out_size, void* d_ws, size_t ws_size, hipStream_t stream) {
    static int grid = 0;
    if (grid == 0) {
        if (n_in != 18 || out_size != T * D || ws_size < WS_END) { fprintf(stderr, "kernel_launch: unexpected shapes (n_in %d out %d ws %zu)\n", n_in, out_size, ws_size); grid = -1; return; }
        int dev = 0, cus = 0, per_cu = 0;
        hipGetDevice(&dev);
        hipDeviceGetAttribute(&cus, hipDeviceAttributeMultiprocessorCount, dev);
        if (hipFuncSetAttribute((const void*)fwd_kernel, hipFuncAttributeMaxDynamicSharedMemorySize, LDS_BYTES) != hipSuccess) { fprintf(stderr, "kernel_launch: hipFuncSetAttribute failed\n"); grid = -1; return; }
        if (hipOccupancyMaxActiveBlocksPerMultiprocessor(&per_cu, (const void*)fwd_kernel, 512, LDS_BYTES) != hipSuccess || per_cu < 1) { fprintf(stderr, "kernel_launch: occupancy query says %d\n", per_cu); per_cu = 1; }
        (void)hipGetLastError();
        grid = cus;
    }
    if (grid < 0) return;
    hipMemsetAsync((char*)d_ws + WS_CTL, 0, CTL_BYTES, stream);
    Params p{};
    p.xp = (const float*)d_in[0]; p.xs = (const float*)d_in[1]; p.cp = (const float*)d_in[2]; p.cs = (const float*)d_in[3];
    p.w_mod = (const float*)d_in[4]; p.b_mod = (const float*)d_in[5]; p.norm_g = (const float*)d_in[6];
    p.wg = (const float*)d_in[7]; p.wu = (const float*)d_in[8]; p.wd = (const float*)d_in[9];
    p.w_in = (const float*)d_in[10]; p.w_out = (const float*)d_in[11]; p.lbf = (const float*)d_in[12]; p.lbb = (const float*)d_in[13];
    p.hgn = (const float*)d_in[14]; p.qng = (const float*)d_in[15]; p.kng = (const float*)d_in[16]; p.rpb = (const float*)d_in[17];
    p.out = (float*)d_out; p.ws = (unsigned char*)d_ws;
#if N_LAUNCH_MODE == 1
    p.ph_lo = 0; p.ph_hi = NPHASE;
    void* args[] = {&p};
    hipError_t e = hipLaunchCooperativeKernel((const void*)fwd_kernel, dim3(grid), dim3(512), args, LDS_BYTES, stream);
    if (e != hipSuccess) fprintf(stderr, "cooperative launch failed: %s (grid %d)\n", hipGetErrorString(e), grid);
#else
    for (int ph = 0; ph < NPHASE; ++ph) {
        p.ph_lo = ph; p.ph_hi = ph + 1;
        hipLaunchKernelGGL(fwd_kernel, dim3(grid), dim3(512), LDS_BYTES, stream, p);
    }
#endif
}
```
